# Optimizing an MI355X kernel written in HIP

```python
import jax, jax.numpy as jnp
from jax import lax
import numpy as np

D_MODEL = 1024
BATCH = 4
SEQ = 4096
DEPTH = 4

GRID_W = 64
CTX_LEN = 256
HEAD_DIM = 64
EPS = 1e-6
NEG_INF = -1e30
A_HEADS = 8
A_KV_HEADS = 2
A_GROUP = A_HEADS // A_KV_HEADS
A_WINDOW = 128
A_BLOCK = 128
A_WIDTH = A_HEADS * HEAD_DIM
A_KV_WIDTH = A_KV_HEADS * HEAD_DIM
ROPE_BASE = 10000.0
B_GROUPS = 4
B_WIDTH = B_GROUPS * HEAD_DIM
CONV_W = 3
R_HEADS = 4
R_WIDTH = R_HEADS * HEAD_DIM
R_CHUNK = 128
F_GROUPS = 4
F_WIDTH = F_GROUPS * HEAD_DIM
N_BRANCH = 4

IN_NAMES = ("a_q", "a_k", "a_v", "a_z", "b_u", "b_b", "b_c", "b_z", "r_q", "r_k", "r_v", "r_z", "f_u", "f_z", "merge")
IN_SIZES = (A_WIDTH, A_KV_WIDTH, A_KV_WIDTH, A_WIDTH, B_WIDTH, B_WIDTH, B_WIDTH, B_WIDTH,
            R_WIDTH, R_WIDTH, R_WIDTH, R_WIDTH, F_WIDTH, F_WIDTH, N_BRANCH * D_MODEL)
IN_WIDTH = sum(IN_SIZES)
CTX_KV_NAMES = ("a_k", "a_v", "r_k", "r_v")

kernel_name = "hybrid_gated_branch_diffusion_trunk"


def _rmsnorm(x, g):
    xf = x.astype(jnp.float32)
    y = xf * lax.rsqrt(jnp.mean(xf * xf, axis=-1, keepdims=True) + EPS)
    return (y * g.astype(jnp.float32)).astype(x.dtype)


def _head_norm(y):
    mu = jnp.mean(y, axis=-1, keepdims=True)
    var = jnp.mean(jnp.square(y - mu), axis=-1, keepdims=True)
    return (y - mu) * lax.rsqrt(var + EPS)


def _in_proj(h, w_in, names):
    offs = np.cumsum((0,) + IN_SIZES)
    sel = [i for i, nm in enumerate(IN_NAMES) if nm in names]
    if len(sel) == len(IN_NAMES):
        w = w_in
    else:
        w = jnp.concatenate([w_in[:, int(offs[i]):int(offs[i + 1])] for i in sel], axis=1)
    p = h @ w
    sizes = [IN_SIZES[i] for i in sel]
    parts = jnp.split(p, [int(s) for s in np.cumsum(sizes)[:-1]], axis=-1)
    return {IN_NAMES[i]: part for i, part in zip(sel, parts)}


def _split_heads(t, h):
    b, n, _ = t.shape
    return t.reshape(b, n, h, HEAD_DIM)


def _axial_rope(n):
    rows = n // GRID_W
    row = jnp.broadcast_to(jnp.arange(rows)[:, None], (rows, GRID_W)).reshape(-1).astype(jnp.float32)
    col = jnp.broadcast_to(jnp.arange(GRID_W)[None, :], (rows, GRID_W)).reshape(-1).astype(jnp.float32)
    half = HEAD_DIM // 2
    inv = ROPE_BASE ** (-jnp.arange(0, half, 2, dtype=jnp.float32) / half)
    ang = jnp.stack([row[:, None] * inv, col[:, None] * inv], axis=1)
    return jnp.cos(ang), jnp.sin(ang)


def _apply_rope(t, cos, sin):
    b, n, h, d = t.shape
    t = t.reshape(b, n, h, 2, 2, d // 4)
    t1, t2 = t[..., 0, :], t[..., 1, :]
    c = cos[None, :, None].astype(t.dtype)
    s = sin[None, :, None].astype(t.dtype)
    out = jnp.stack([t1 * c - t2 * s, t2 * c + t1 * s], axis=-2)
    return out.reshape(b, n, h, d)


def _window_attention(q, k, v, kc, vc, sink):
    b, s, h, d = q.shape
    nb = s // A_BLOCK
    scale = d ** -0.5
    qb = q.reshape(b, nb, A_BLOCK, A_KV_HEADS, A_GROUP, d)
    pad = ((0, 0), (A_BLOCK, A_BLOCK), (0, 0), (0, 0))
    kp = jnp.pad(k, pad).reshape(b, nb + 2, A_BLOCK, A_KV_HEADS, d)
    vp = jnp.pad(v, pad).reshape(b, nb + 2, A_BLOCK, A_KV_HEADS, d)
    kb = jnp.concatenate([kp[:, :-2], kp[:, 1:-1], kp[:, 2:]], axis=2)
    vb = jnp.concatenate([vp[:, :-2], vp[:, 1:-1], vp[:, 2:]], axis=2)
    s_loc = jnp.einsum("bnqkgd,bnjkd->bnkgqj", qb, kb).astype(jnp.float32) * scale
    blk = jnp.arange(nb)[:, None] * A_BLOCK
    qpos = blk + jnp.arange(A_BLOCK)[None, :]
    kpos = blk - A_BLOCK + jnp.arange(3 * A_BLOCK)[None, :]
    valid = ((jnp.abs(qpos[:, :, None] - kpos[:, None, :]) <= A_WINDOW)
             & (kpos[:, None, :] >= 0) & (kpos[:, None, :] < s))
    s_loc = jnp.where(valid[None, :, None, None], s_loc, NEG_INF)
    s_ctx = jnp.einsum("bnqkgd,bjkd->bnkgqj", qb, kc).astype(jnp.float32) * scale
    sink_l = jnp.broadcast_to(sink.reshape(A_KV_HEADS, A_GROUP)[:, :, None, None].astype(jnp.float32),
                              s_loc.shape[:-1] + (1,))
    p = jax.nn.softmax(jnp.concatenate([s_loc, s_ctx, sink_l], axis=-1), axis=-1)
    nloc = 3 * A_BLOCK
    nctx = kc.shape[1]
    o = (jnp.einsum("bnkgqj,bnjkd->bnqkgd", p[..., :nloc].astype(v.dtype), vb)
         + jnp.einsum("bnkgqj,bjkd->bnqkgd", p[..., nloc:nloc + nctx].astype(v.dtype), vc))
    return o.reshape(b, s, h * d)


def _context_attention(qc, kc, vc, sink):
    b, L, h, d = qc.shape
    qg = qc.reshape(b, L, A_KV_HEADS, A_GROUP, d)
    sc = jnp.einsum("bqkgd,bjkd->bkgqj", qg, kc).astype(jnp.float32) * (d ** -0.5)
    sink_l = jnp.broadcast_to(sink.reshape(A_KV_HEADS, A_GROUP)[:, :, None, None].astype(jnp.float32),
                              sc.shape[:-1] + (1,))
    p = jax.nn.softmax(jnp.concatenate([sc, sink_l], axis=-1), axis=-1)
    o = jnp.einsum("bkgqj,bjkd->bqkgd", p[..., :L].astype(vc.dtype), vc)
    return o.reshape(b, L, h * d)


def _short_conv(u, w, bias):
    up = jnp.pad(u, ((0, 0), (1, 1), (0, 0)))
    return up[:, :-2] * w[0] + up[:, 1:-1] * w[1] + up[:, 2:] * w[2] + bias


def _retention_states(k, v, lg, r0):
    b, h, n, d = k.shape
    nc = n // R_CHUNK
    idx = jnp.arange(R_CHUNK, dtype=jnp.float32)
    kc_ = k.reshape(b, h, nc, R_CHUNK, d)
    vc_ = v.reshape(b, h, nc, R_CHUNK, d)
    zeta = jnp.exp(lg[:, None] * (R_CHUNK - 1 - idx))
    incr = jnp.einsum("bhncd,bhnce->nbhde", kc_ * zeta[None, :, None, :, None], vc_)
    g_chunk = jnp.exp(lg * R_CHUNK)[None, :, None, None]

    def step(r, u):
        return g_chunk * r + u, r

    r_fin, r_prev = lax.scan(step, r0, incr)
    return r_prev, r_fin


def _retention_outputs(q, k, v, lg, r_prev):
    b, h, n, d = q.shape
    nc = n // R_CHUNK
    idx = jnp.arange(R_CHUNK, dtype=jnp.float32)
    q_ = q.reshape(b, h, nc, R_CHUNK, d)
    k_ = k.reshape(b, h, nc, R_CHUNK, d)
    v_ = v.reshape(b, h, nc, R_CHUNK, d)
    diff = idx[:, None] - idx[None, :]
    decay = jnp.where(diff >= 0, jnp.exp(lg[:, None, None] * jnp.maximum(diff, 0.0)), 0.0)
    sc = jnp.einsum("bhncd,bhnmd->bhncm", q_, k_) * decay[None, :, None]
    inner = jnp.einsum("bhncm,bhnme->bhnce", sc, v_)
    xi = jnp.exp(lg[:, None] * (idx + 1.0))
    cross = jnp.einsum("bhncd,nbhde->bhnce", q_ * xi[None, :, None, :, None], r_prev)
    return (inner + cross).reshape(b, h, n, d)


def _bidir_retention(q, k, v, qc, kc, vc, log_gamma):
    b, h, _, d = q.shape
    r0 = jnp.zeros((b, h, d, d), jnp.float32)
    y, yc = 0.0, 0.0
    for direction in range(2):
        lg = log_gamma[direction]
        fl = (lambda t: jnp.flip(t, axis=2)) if direction == 1 else (lambda t: t)
        prev_c, state_c = _retention_states(fl(kc), fl(vc), lg, r0)
        prev_x, _ = _retention_states(fl(k), fl(v), lg, state_c)
        y = y + fl(_retention_outputs(fl(q), fl(k), fl(v), lg, prev_x))
        if qc is not None:
            yc = yc + fl(_retention_outputs(fl(qc), fl(kc), fl(vc), lg, prev_c))
    y = _head_norm(y)
    yc = _head_norm(yc) if qc is not None else None
    return y, yc


def _fourier(u):
    b, n, _ = u.shape
    ug = u.reshape(b, n, F_GROUPS, HEAD_DIM).astype(jnp.float32)
    y = jnp.fft.fft2(ug, axes=(1, 3), norm="ortho").real
    return y.reshape(b, n, F_WIDTH).astype(u.dtype)


def _merge(ys, zs, merge_logits, w_os, w_out):
    b, n, _ = merge_logits.shape
    gates = jax.nn.sigmoid(merge_logits.reshape(b, n, N_BRANCH, D_MODEL))
    total = 0.0
    for i in range(N_BRANCH):
        total = total + gates[:, :, i] * ((ys[i] * jax.nn.silu(zs[i])) @ w_os[i])
    return total @ w_out


def _to_heads_first(t):
    return jnp.transpose(t, (0, 2, 1, 3)).astype(jnp.float32)


def _from_heads_first(t, dtype):
    b, h, n, d = t.shape
    return jnp.transpose(t, (0, 2, 1, 3)).reshape(b, n, h * d).astype(dtype)


def _layer(x, xc, mod_x, mod_c, cos, sin, g_pre, g_post, w_in, sink, conv_w, conv_b,
           ret_decay, w_o_attn, w_o_conv, w_o_ret, w_o_fourier, w_out, update_ctx):
    shift_x, scale_x, gate_x = jnp.split(mod_x, 3, axis=-1)
    shift_c, scale_c, gate_c = jnp.split(mod_c, 3, axis=-1)
    hx = _rmsnorm(x, g_pre) * (1.0 + scale_x) + shift_x
    hc = _rmsnorm(xc, g_pre) * (1.0 + scale_c) + shift_c
    px = _in_proj(hx, w_in, IN_NAMES)
    pc = _in_proj(hc, w_in, IN_NAMES if update_ctx else CTX_KV_NAMES)
    w_os = (w_o_attn, w_o_conv, w_o_ret, w_o_fourier)
    k_scale = HEAD_DIM ** -0.5

    q_a = _apply_rope(_split_heads(px["a_q"], A_HEADS), cos, sin)
    k_a = _apply_rope(_split_heads(px["a_k"], A_KV_HEADS), cos, sin)
    v_a = _split_heads(px["a_v"], A_KV_HEADS)
    k_ac = _split_heads(pc["a_k"], A_KV_HEADS)
    v_ac = _split_heads(pc["a_v"], A_KV_HEADS)
    y_a = _window_attention(q_a, k_a, v_a, k_ac, v_ac, sink)

    y_b = px["b_b"] * _short_conv(px["b_c"] * px["b_u"], conv_w, conv_b)

    log_gamma = jax.nn.log_sigmoid(ret_decay.astype(jnp.float32))
    q_r = _to_heads_first(_apply_rope(_split_heads(px["r_q"], R_HEADS), cos, sin))
    k_r = _to_heads_first(_apply_rope(_split_heads(px["r_k"], R_HEADS), cos, sin)) * k_scale
    v_r = _to_heads_first(_split_heads(px["r_v"], R_HEADS))
    k_rc = _to_heads_first(_split_heads(pc["r_k"], R_HEADS)) * k_scale
    v_rc = _to_heads_first(_split_heads(pc["r_v"], R_HEADS))
    q_rc = _to_heads_first(_split_heads(pc["r_q"], R_HEADS)) if update_ctx else None
    y_r, y_rc = _bidir_retention(q_r, k_r, v_r, q_rc, k_rc, v_rc, log_gamma)
    y_r = _from_heads_first(y_r, x.dtype)

    y_f = _fourier(px["f_u"])

    y = _merge((y_a, y_b, y_r, y_f), (px["a_z"], px["b_z"], px["r_z"], px["f_z"]), px["merge"], w_os, w_out)
    x_new = x + gate_x * _rmsnorm(y, g_post)
    if not update_ctx:
        return x_new, xc

    yc_a = _context_attention(_split_heads(pc["a_q"], A_HEADS), k_ac, v_ac, sink)
    yc_b = pc["b_b"] * _short_conv(pc["b_c"] * pc["b_u"], conv_w, conv_b)
    yc_r = _from_heads_first(y_rc, xc.dtype)
    yc_f = _fourier(pc["f_u"])
    yc = _merge((yc_a, yc_b, yc_r, yc_f), (pc["a_z"], pc["b_z"], pc["r_z"], pc["f_z"]), pc["merge"], w_os, w_out)
    xc_new = xc + gate_c * _rmsnorm(yc, g_post)
    return x_new, xc_new


def setup_inputs(seed: int = 0) -> dict:
    key = jax.random.key(seed)
    ks = jax.random.split(key, 18)
    f32 = jnp.float32

    def nrm(k, shape, scale):
        return jax.random.normal(k, shape, f32) * scale

    decay_base = jnp.log(2.0 ** (5.0 + jnp.arange(R_HEADS, dtype=f32)) - 1.0)
    return {
        "x": nrm(ks[0], (BATCH, SEQ, D_MODEL), 1.0),
        "c": nrm(ks[1], (BATCH, D_MODEL), 1.0),
        "ctx": nrm(ks[2], (BATCH, CTX_LEN, D_MODEL), 1.0),
        "c_ctx": nrm(ks[3], (D_MODEL,), 1.0),
        "w_ada": nrm(ks[4], (DEPTH, D_MODEL, 3 * D_MODEL), 0.5 * D_MODEL ** -0.5),
        "b_ada": nrm(ks[5], (DEPTH, 3 * D_MODEL), 0.02),
        "norm_pre": 1.0 + nrm(ks[6], (DEPTH, D_MODEL), 0.05),
        "norm_post": 1.0 + nrm(ks[7], (DEPTH, D_MODEL), 0.05),
        "w_in": nrm(ks[8], (DEPTH, D_MODEL, IN_WIDTH), D_MODEL ** -0.5),
        "attn_sink": nrm(ks[9], (DEPTH, A_HEADS), 0.5),
        "conv_w": nrm(ks[10], (DEPTH, CONV_W, B_WIDTH), CONV_W ** -0.5),
        "conv_b": nrm(ks[11], (DEPTH, B_WIDTH), 0.02),
        "ret_decay": decay_base + nrm(ks[12], (DEPTH, 2, R_HEADS), 0.1),
        "w_o_attn": nrm(ks[13], (DEPTH, A_WIDTH, D_MODEL), A_WIDTH ** -0.5),
        "w_o_conv": nrm(ks[14], (DEPTH, B_WIDTH, D_MODEL), B_WIDTH ** -0.5),
        "w_o_ret": nrm(ks[15], (DEPTH, R_WIDTH, D_MODEL), R_WIDTH ** -0.5),
        "w_o_fourier": nrm(ks[16], (DEPTH, F_WIDTH, D_MODEL), F_WIDTH ** -0.5),
        "w_out": nrm(ks[17], (DEPTH, D_MODEL, D_MODEL), D_MODEL ** -0.5),
    }


def reference(x, c, ctx, c_ctx, w_ada, b_ada, norm_pre, norm_post, w_in, attn_sink, conv_w, conv_b,
              ret_decay, w_o_attn, w_o_conv, w_o_ret, w_o_fourier, w_out):
    n = x.shape[1]
    cos, sin = _axial_rope(n)
    silu_c = jax.nn.silu(c)
    silu_cc = jax.nn.silu(c_ctx)
    xc = ctx
    for l in range(DEPTH):
        mod_x = (silu_c @ w_ada[l] + b_ada[l])[:, None, :]
        mod_c = (silu_cc @ w_ada[l] + b_ada[l])[None, None, :]
        x, xc = _layer(x, xc, mod_x, mod_c, cos, sin, norm_pre[l], norm_post[l], w_in[l], attn_sink[l],
                       conv_w[l], conv_b[l], ret_decay[l], w_o_attn[l], w_o_conv[l], w_o_ret[l],
                       w_o_fourier[l], w_out[l], l < DEPTH - 1)
    return x
```

```cpp
#include <hip/hip_runtime.h>
#include <cstdint>
#include <cstdio>

constexpr int D = 1024, NB = 4, S = 4096, L = 256, DEPTH = 4, INW = 7936;
constexpr int RB = S + L;
constexpr int O_AQ = 0, O_AK = 512, O_AV = 640, O_AZ = 768, O_BU = 1280, O_BB = 1536, O_BC = 1792, O_BZ = 2048,
              O_RQ = 2304, O_RK = 2560, O_RV = 2816, O_RZ = 3072, O_FU = 3328, O_FZ = 3584, O_MG = 3840;
constexpr float EPS = 1e-6f;

__device__ __forceinline__ float siluf(float v) { return v / (1.f + expf(-v)); }
__device__ __forceinline__ float sigmf(float v) { return 1.f / (1.f + expf(-v)); }

__global__ void k_mod(const float* c, const float* cctx, const float* w_ada, const float* b_ada, float* mod) {
    const int l = blockIdx.z, src = blockIdx.y, col = blockIdx.x * 256 + threadIdx.x;
    const float* sv = src < 4 ? c + src * D : cctx;
    const float* w = w_ada + (size_t)l * D * 3 * D;
    float acc = 0.f;
    for (int k = 0; k < D; ++k) acc += siluf(sv[k]) * w[(size_t)k * 3 * D + col];
    mod[((size_t)l * 5 + src) * 3 * D + col] = acc + b_ada[l * 3 * D + col];
}

__global__ void k_hx(const float* xl, const float* xc, const float* modx, const float* modc, const float* g, float* hx) {
    const int r = blockIdx.x, tid = threadIdx.x;
    const float* x = r < S ? xl + (size_t)r * D : xc + (size_t)(r - S) * D;
    const float* mod = r < S ? modx : modc;
    __shared__ float red[256];
    float v[4], ss = 0.f;
    for (int i = 0; i < 4; ++i) { v[i] = x[tid + 256 * i]; ss += v[i] * v[i]; }
    red[tid] = ss; __syncthreads();
    for (int o = 128; o > 0; o >>= 1) { if (tid < o) red[tid] += red[tid + o]; __syncthreads(); }
    const float rs = rsqrtf(red[0] / D + EPS);
    for (int i = 0; i < 4; ++i) { const int cidx = tid + 256 * i; hx[(size_t)r * D + cidx] = v[i] * rs * g[cidx] * (1.f + mod[D + cidx]) + mod[cidx]; }
}

__global__ void k_gemm(const float* A, int lda, const float* Bm, int ldb, float* C, int ldc, int K) {
    __shared__ float As[16][65], Bs[16][65];
    const int tid = threadIdx.x, tx = tid & 15, ty = tid >> 4, m0 = blockIdx.y * 64, n0 = blockIdx.x * 64;
    float acc[4][4] = {};
    for (int k0 = 0; k0 < K; k0 += 16) {
        for (int i = tid; i < 1024; i += 256) { const int m = i >> 4, k = i & 15; As[k][m] = A[(size_t)(m0 + m) * lda + k0 + k]; }
        for (int i = tid; i < 1024; i += 256) { const int k = i >> 6, n = i & 63; Bs[k][n] = Bm[(size_t)(k0 + k) * ldb + n0 + n]; }
        __syncthreads();
#pragma unroll
        for (int k = 0; k < 16; ++k) {
            float a[4], b[4];
#pragma unroll
            for (int i = 0; i < 4; ++i) { a[i] = As[k][ty * 4 + i]; b[i] = Bs[k][tx * 4 + i]; }
#pragma unroll
            for (int i = 0; i < 4; ++i)
#pragma unroll
                for (int j = 0; j < 4; ++j) acc[i][j] += a[i] * b[j];
        }
        __syncthreads();
    }
    for (int i = 0; i < 4; ++i) for (int j = 0; j < 4; ++j) C[(size_t)(m0 + ty * 4 + i) * ldc + n0 + tx * 4 + j] = acc[i][j];
}

__global__ void k_rope(float* px) {
    const int r = blockIdx.x, tid = threadIdx.x;
    float* row = px + (size_t)r * INW;
    if (r < S) {
        for (int p = tid; p < 18 * 32; p += 256) {
            const int hh = p >> 5, q = p & 31, axis = q >> 4, j = q & 15;
            int base;
            if (hh < 8) base = O_AQ + hh * 64; else if (hh < 10) base = O_AK + (hh - 8) * 64; else if (hh < 14) base = O_RQ + (hh - 10) * 64; else base = O_RK + (hh - 14) * 64;
            const int pos = axis ? (r & 63) : (r >> 6);
            const float inv = powf(10000.f, -(float)j / 16.f);
            const float ang = (float)pos * inv, cs = cosf(ang), sn = sinf(ang);
            const float t1 = row[base + axis * 32 + j], t2 = row[base + axis * 32 + 16 + j];
            row[base + axis * 32 + j] = t1 * cs - t2 * sn; row[base + axis * 32 + 16 + j] = t2 * cs + t1 * sn;
        }
    }
    __syncthreads();
    row[O_RK + tid] *= 0.125f;
}

__global__ void __launch_bounds__(64) k_attn(const float* px, const float* sink, float* ya) {
    const int r = blockIdx.x, h = blockIdx.y, lane = threadIdx.x, kvh = h >> 2;
    __shared__ float sc[640]; __shared__ int kidx[640]; __shared__ float qs[64];
    qs[lane] = px[(size_t)r * INW + O_AQ + h * 64 + lane];
    int nk = 0;
    int lo = 0, hi = -1;
    if (r < S) { lo = r - 128 < 0 ? 0 : r - 128; hi = r + 128 > S - 1 ? S - 1 : r + 128; }
    const int nloc = hi - lo + 1;
    nk = nloc + L;
    __syncthreads();
    for (int i = lane; i < nk; i += 64) {
        const int kr = i < nloc ? lo + i : S + (i - nloc);
        const float* kp = px + (size_t)kr * INW + O_AK + kvh * 64;
        float d = 0.f;
#pragma unroll 8
        for (int e = 0; e < 64; ++e) d += qs[e] * kp[e];
        sc[i] = d * 0.125f; kidx[i] = kr;
    }
    __syncthreads();
    const float sk = sink[h];
    float mx = sk;
    for (int i = 0; i < nk; ++i) mx = fmaxf(mx, sc[i]);
    float den = expf(sk - mx), o = 0.f;
    for (int i = 0; i < nk; ++i) { const float p = expf(sc[i] - mx); den += p; o += p * px[(size_t)kidx[i] * INW + O_AV + kvh * 64 + lane]; }
    ya[(size_t)r * 512 + h * 64 + lane] = o / den;
}

__global__ void k_conv(const float* px, const float* cw, const float* cb, float* yb) {
    const int r = blockIdx.x, c = threadIdx.x;
    const bool lat = r < S; const int t = lat ? r : r - S, n = lat ? S : L;
    const float* row = px + (size_t)r * INW;
    const float u1 = row[O_BC + c] * row[O_BU + c];
    const float u0 = t > 0 ? row[O_BC + c - INW] * row[O_BU + c - INW] : 0.f;
    const float u2 = t < n - 1 ? row[O_BC + c + INW] * row[O_BU + c + INW] : 0.f;
    yb[(size_t)r * 256 + c] = row[O_BB + c] * (u0 * cw[c] + u1 * cw[256 + c] + u2 * cw[512 + c] + cb[c]);
}

__global__ void __launch_bounds__(64) k_ret(const float* px, const float* ret_decay, float* ydir) {
    const int h = blockIdx.x, dir = blockIdx.y, e = threadIdx.x;
    const float dec = ret_decay[dir * 4 + h];
    const float lg = -log1pf(expf(-dec));
    const float gamma = expf(lg);
    float Sm[64];
#pragma unroll
    for (int d = 0; d < 64; ++d) Sm[d] = 0.f;
    for (int step = 0; step < RB; ++step) {
        int r;
        if (dir == 0) r = step < L ? S + step : step - L;
        else r = step < L ? S + (L - 1 - step) : S - 1 - (step - L);
        const float* row = px + (size_t)r * INW;
        const float v = row[O_RV + h * 64 + e];
        float y = 0.f;
#pragma unroll
        for (int d = 0; d < 64; ++d) { Sm[d] = gamma * Sm[d] + row[O_RK + h * 64 + d] * v; y += row[O_RQ + h * 64 + d] * Sm[d]; }
        ydir[((size_t)dir * RB + r) * 256 + h * 64 + e] = y;
    }
}

__global__ void k_headnorm(const float* ydir, float* yr) {
    const int r = blockIdx.x, tid = threadIdx.x, lane = tid & 63;
    float v = ydir[(size_t)r * 256 + tid] + ydir[((size_t)RB + r) * 256 + tid];
    float s = v;
    for (int o = 1; o < 64; o <<= 1) s += __shfl_xor(s, o);
    const float mu = s / 64.f; const float dv = v - mu;
    float q = dv * dv;
    for (int o = 1; o < 64; o <<= 1) q += __shfl_xor(q, o);
    yr[(size_t)r * 256 + tid] = dv * rsqrtf(q / 64.f + EPS);
    (void)lane;
}

__global__ void k_fch(const float* px, float* uc, float* us) {
    const int r = blockIdx.x, tid = threadIdx.x, g = tid >> 6, cp = tid & 63;
    __shared__ float u[256]; __shared__ float ct[64], st[64];
    u[tid] = px[(size_t)r * INW + O_FU + tid];
    if (tid < 64) { ct[tid] = cospif(tid / 32.f); st[tid] = sinpif(tid / 32.f); }
    __syncthreads();
    float a = 0.f, b = 0.f;
    for (int c = 0; c < 64; ++c) { const int ph = (c * cp) & 63; a += u[g * 64 + c] * ct[ph]; b += u[g * 64 + c] * st[ph]; }
    uc[(size_t)r * 256 + tid] = a; us[(size_t)r * 256 + tid] = b;
}
__global__ void k_fpos(const float* uc, const float* us, float* yf, int r0, int N) {
    extern __shared__ float tab[];
    const int k = blockIdx.x, ch = threadIdx.x;
    for (int i = ch; i < N; i += 256) { tab[i] = cospif(2.f * i / (float)N); tab[N + i] = sinpif(2.f * i / (float)N); }
    __syncthreads();
    float acc = 0.f;
    for (int n = 0; n < N; ++n) { const int ph = (k * n) & (N - 1); acc += tab[ph] * uc[(size_t)(r0 + n) * 256 + ch] - tab[N + ph] * us[(size_t)(r0 + n) * 256 + ch]; }
    yf[(size_t)(r0 + k) * 256 + ch] = acc * rsqrtf((float)N * 64.f);
}

__global__ void k_ymul(const float* px, const float* ya, const float* yb, const float* yr, const float* yf, float* Y) {
    const int r = blockIdx.x; const float* row = px + (size_t)r * INW;
    for (int c = threadIdx.x; c < 1280; c += 256) {
        float y, z;
        if (c < 512) { y = ya[(size_t)r * 512 + c]; z = row[O_AZ + c]; }
        else if (c < 768) { y = yb[(size_t)r * 256 + c - 512]; z = row[O_BZ + c - 512]; }
        else if (c < 1024) { y = yr[(size_t)r * 256 + c - 768]; z = row[O_RZ + c - 768]; }
        else { y = yf[(size_t)r * 256 + c - 1024]; z = row[O_FZ + c - 1024]; }
        Y[(size_t)r * 1280 + c] = y * siluf(z);
    }
}
__global__ void k_total(const float* px, const float* P, float* T) {
    const int r = blockIdx.x; const float* row = px + (size_t)r * INW + O_MG;
    for (int c = threadIdx.x; c < D; c += 256) {
        float t = 0.f;
        for (int i = 0; i < 4; ++i) t += sigmf(row[i * D + c]) * P[((size_t)i * RB + r) * D + c];
        T[(size_t)r * D + c] = t;
    }
}
__global__ void k_post(float* xl, float* xc, const float* out, const float* modx, const float* modc, const float* g, int upd_ctx) {
    const int r = blockIdx.x, tid = threadIdx.x;
    if (r >= S && !upd_ctx) return;
    float* x = r < S ? xl + (size_t)r * D : xc + (size_t)(r - S) * D;
    const float* mod = r < S ? modx : modc;
    __shared__ float red[256];
    float v[4], ss = 0.f;
    for (int i = 0; i < 4; ++i) { v[i] = out[(size_t)r * D + tid + 256 * i]; ss += v[i] * v[i]; }
    red[tid] = ss; __syncthreads();
    for (int o = 128; o > 0; o >>= 1) { if (tid < o) red[tid] += red[tid + o]; __syncthreads(); }
    const float rs = rsqrtf(red[0] / D + EPS);
    for (int i = 0; i < 4; ++i) { const int cidx = tid + 256 * i; x[cidx] += mod[2 * D + cidx] * (v[i] * rs * g[cidx]); }
}

extern "C" void kernel_launch(void* const* d_in, const int* in_sizes, int n_in, void* d_out, int out_size, void* d_ws, size_t ws_size, hipStream_t stream) {
    const float* x = (const float*)d_in[0]; const float* c = (const float*)d_in[1]; const float* ctx = (const float*)d_in[2]; const float* cctx = (const float*)d_in[3];
    const float* w_ada = (const float*)d_in[4]; const float* b_ada = (const float*)d_in[5]; const float* norm_pre = (const float*)d_in[6]; const float* norm_post = (const float*)d_in[7];
    const float* w_in = (const float*)d_in[8]; const float* sink = (const float*)d_in[9]; const float* conv_w = (const float*)d_in[10]; const float* conv_b = (const float*)d_in[11];
    const float* ret_decay = (const float*)d_in[12]; const float* w_o_attn = (const float*)d_in[13]; const float* w_o_conv = (const float*)d_in[14]; const float* w_o_ret = (const float*)d_in[15];
    const float* w_o_f = (const float*)d_in[16]; const float* w_out = (const float*)d_in[17];
    float* xo = (float*)d_out;
    char* ws = (char*)d_ws; size_t off = 0;
    auto take = [&](size_t nfloat) { float* p = (float*)(ws + off); off += ((nfloat * 4 + 255) / 256) * 256; return p; };
    float* mod = take((size_t)DEPTH * 5 * 3 * D);
    float* xc = take((size_t)NB * L * D);
    float* hx = take((size_t)RB * D);
    float* px = take((size_t)RB * INW);
    float* ya = take((size_t)RB * 512);
    float* yb = take((size_t)RB * 256);
    float* ydir = take((size_t)2 * RB * 256);
    float* yr = take((size_t)RB * 256);
    float* uc = take((size_t)RB * 256);
    float* us = take((size_t)RB * 256);
    float* yf = take((size_t)RB * 256);
    float* Y = take((size_t)RB * 1280);
    float* P = take((size_t)4 * RB * D);
    float* T = take((size_t)RB * D);
    float* outb = take((size_t)RB * D);
    if (off > ws_size) { fprintf(stderr, "ws too small %zu > %zu\n", off, ws_size); return; }
    hipMemcpyAsync(xo, x, (size_t)NB * S * D * 4, hipMemcpyDeviceToDevice, stream);
    hipMemcpyAsync(xc, ctx, (size_t)NB * L * D * 4, hipMemcpyDeviceToDevice, stream);
    k_mod<<<dim3(12, 5, 4), 256, 0, stream>>>(c, cctx, w_ada, b_ada, mod);
    for (int l = 0; l < DEPTH; ++l) {
        const int upd = l < DEPTH - 1;
        for (int b = 0; b < NB; ++b) {
            float* xl = xo + (size_t)b * S * D; float* xcb = xc + (size_t)b * L * D;
            const float* modx = mod + ((size_t)l * 5 + b) * 3 * D; const float* modc = mod + ((size_t)l * 5 + 4) * 3 * D;
            k_hx<<<RB, 256, 0, stream>>>(xl, xcb, modx, modc, norm_pre + l * D, hx);
            k_gemm<<<dim3(INW / 64, RB / 64), 256, 0, stream>>>(hx, D, w_in + (size_t)l * D * INW, INW, px, INW, D);
            k_rope<<<RB, 256, 0, stream>>>(px);
            k_attn<<<dim3(RB, 8), 64, 0, stream>>>(px, sink + l * 8, ya);
            k_conv<<<RB, 256, 0, stream>>>(px, conv_w + l * 768, conv_b + l * 256, yb);
            k_ret<<<dim3(4, 2), 64, 0, stream>>>(px, ret_decay + l * 8, ydir);
            k_headnorm<<<RB, 256, 0, stream>>>(ydir, yr);
            k_fch<<<RB, 256, 0, stream>>>(px, uc, us);
            k_fpos<<<S, 256, 2 * S * 4, stream>>>(uc, us, yf, 0, S);
            k_fpos<<<L, 256, 2 * L * 4, stream>>>(uc, us, yf, S, L);
            k_ymul<<<RB, 256, 0, stream>>>(px, ya, yb, yr, yf, Y);
            k_gemm<<<dim3(D / 64, RB / 64), 256, 0, stream>>>(Y, 1280, w_o_attn + (size_t)l * 512 * D, D, P, D, 512);
            k_gemm<<<dim3(D / 64, RB / 64), 256, 0, stream>>>(Y + 512, 1280, w_o_conv + (size_t)l * 256 * D, D, P + (size_t)RB * D, D, 256);
            k_gemm<<<dim3(D / 64, RB / 64), 256, 0, stream>>>(Y + 768, 1280, w_o_ret + (size_t)l * 256 * D, D, P + (size_t)2 * RB * D, D, 256);
            k_gemm<<<dim3(D / 64, RB / 64), 256, 0, stream>>>(Y + 1024, 1280, w_o_f + (size_t)l * 256 * D, D, P + (size_t)3 * RB * D, D, 256);
            k_total<<<RB, 256, 0, stream>>>(px, P, T);
            k_gemm<<<dim3(D / 64, RB / 64), 256, 0, stream>>>(T, D, w_out + (size_t)l * D * D, D, outb, D, D);
            k_post<<<RB, 256, 0, stream>>>(xl, xcb, outb, modx, modc, norm_post + l * D, upd);
        }
    }
}
```

```cpp
#ifndef MK_COOP
#define MK_COOP 1
#endif
#include <hip/hip_runtime.h>
#include <hip/hip_cooperative_groups.h>
#include <cstdint>
#include <cstdio>
namespace cg = cooperative_groups;

#define LAS __attribute__((address_space(3)))
typedef unsigned short bf16_t;
typedef short bf16x8 __attribute__((ext_vector_type(8)));
typedef float f32x4 __attribute__((ext_vector_type(4)));
typedef unsigned u32x4 __attribute__((ext_vector_type(4)));
typedef unsigned u32x2 __attribute__((ext_vector_type(2)));

constexpr int D = 1024, NB = 4, S = 4096, L = 256, DEPTH = 4, INW = 7936;
constexpr int LATROWS = NB * S, MROWS = NB * S + NB * L;
constexpr int PXW = 4096, GW = 4096, YW = 1280;
constexpr int C_AQ = 0, C_AK = 512, C_AV = 640, C_AZ = 768, C_BU = 1280, C_BB = 1536, C_BC = 1792, C_BZ = 2048,
              C_RQ = 2304, C_RK = 2560, C_RV = 2816, C_RZ = 3072, C_FC = 3328, C_FS = 3584, C_FZ = 3840;
constexpr int NWAVES = 8, NTHR = 512;
constexpr float EPS = 1e-6f;
constexpr float LOG2E = 1.4426950408889634f;
constexpr float QSCALE = 0.125f * LOG2E;
constexpr int LDS_BYTES = 163840;
#ifndef REP_PHASE
#define REP_PHASE -1
#endif
#ifndef REP_SYNC
#define REP_SYNC 0
#endif
#ifndef PROBE_ATT2
#define PROBE_ATT2 0
#endif
#ifndef PROBE_EPI
#define PROBE_EPI 0
#endif
#ifndef PROBE_EPI2
#define PROBE_EPI2 0
#endif
#ifndef PROBE_ST2
#define PROBE_ST2 0
#endif
#ifndef STAGGER_US
#define STAGGER_US 0
#endif
#ifndef PROBE_NOST
#define PROBE_NOST 0
#endif
#ifndef REP_SUB
#define REP_SUB -1
#endif

constexpr size_t MiB = 1u << 20;
constexpr size_t WS_CTL = 0, WS_MOD = 1 * MiB, WS_ROPE = 1 * MiB + 512 * 1024, WS_SSP = 2 * MiB, WS_WIN = 4 * MiB, WS_WO = 68 * MiB, WS_WOUT = 78 * MiB,
                 WS_XC = 86 * MiB, WS_HX = 90 * MiB, WS_PXA = 124 * MiB, WS_GATES = 260 * MiB, WS_Y = 396 * MiB, WS_INCR = 439 * MiB, WS_GP = 456 * MiB, WS_STATE = 472 * MiB, WS_SSP2 = 481 * MiB, WS_END = 484 * MiB;
constexpr int CTL_BYTES = 32768, CW_Q = 4096  , CW_RC = 4096 + 1024  , CW_F1 = CW_RC + 1024  , CW_SC = CW_F1 + 256  ;
constexpr int LDS_Q = LDS_BYTES - 32;
constexpr size_t WS_FA1 = WS_ROPE + 16384, WS_FA2 = WS_FA1 + 34816;
constexpr size_t WIN_L = (size_t)8192 * 1024 * 2, WO_L = (size_t)1024 * 1280 * 2, WOUT_L = (size_t)1024 * 1024 * 2;

struct P {
    const float *x, *c, *ctx, *cctx, *w_ada, *b_ada, *norm_pre, *norm_post, *w_in, *sink, *conv_w, *conv_b, *ret_decay, *w_o[4], *w_out;
    float* out; unsigned char* ws; int ph_lo, ph_hi, coop, pad;
};

__device__ __forceinline__ float bf2f(unsigned v) { return __builtin_bit_cast(float, v << 16); }
__device__ __forceinline__ unsigned f2bf(float f) { unsigned u = __builtin_bit_cast(unsigned, f); return (u + 0x7fffu + ((u >> 16) & 1u)) >> 16; }
typedef __bf16 bf2_t __attribute__((ext_vector_type(2)));
__device__ __forceinline__ unsigned pk2(float lo, float hi) { bf2_t v; v[0] = (__bf16)lo; v[1] = (__bf16)hi; return __builtin_bit_cast(unsigned, v); }
__device__ __forceinline__ float siluf(float v) { return v * __builtin_amdgcn_rcpf(1.f + __expf(-v)); }
__device__ __forceinline__ float sigmf(float v) { return 1.f / (1.f + __expf(-v)); }
__device__ __forceinline__ float wave_sum(float v) {
#pragma unroll
    for (int o = 1; o < 64; o <<= 1) v += __shfl_xor(v, o);
    return v;
}
__device__ __forceinline__ float wave_max(float v) {
#pragma unroll
    for (int o = 1; o < 64; o <<= 1) v = fmaxf(v, __shfl_xor(v, o));
    return v;
}
#define LDS_WAIT() asm volatile("s_waitcnt lgkmcnt(0)" ::: "memory")

namespace pg8 {
#define PG8_LAS __attribute__((address_space(3)))
constexpr int BM = 256, BK = 64, HALF = 128, HTB = HALF * BK * 2, STAGE_BYTES = 8 * HTB, NXCD = 8, WGM = 4;
__host__ __device__ __forceinline__ int lds_byte(int r, int c) { const int st = (r >> 4) * 2 + (c >> 5), rr = r & 15, cc = c & 31, ob = rr * 64 + cc * 2; return st * 1024 + (ob ^ (((ob >> 9) & 1) << 5)); }
__host__ __device__ __forceinline__ void stage_rc(int b, int& R, int& C) { const int st = b / 1024, sb = b % 1024, swz = sb ^ (((sb >> 9) & 1) << 5); R = (st >> 1) * 16 + swz / 64; C = (st & 1) * 32 + (swz % 64) / 2; }
__host__ __device__ __forceinline__ int perm32(int rho) { const int n = rho >> 4, i = rho & 15; return 8 * (i >> 2) + 4 * n + (i & 3); }

struct Unit { int pm, pn, kofs, nt, br; };
struct Gemm { const bf16_t* A; const bf16_t* Bt; int ld; };

template <int NM, int NN, int WGM = 4> struct StaticOrderT {
    int G, c;
    __device__ void init(int G_, int c_) { G = G_; c = c_; }
    __device__ bool tile(int i, int& pm, int& pn) const {
        constexpr int nwg = NM * NN, q = nwg / NXCD, r = nwg % NXCD, nig = WGM * NN;
        const int Lx = i * G + c; if (Lx >= nwg) return false;
        int wgid = Lx; { const int xcd = wgid % NXCD, off = wgid / NXCD; wgid = (xcd < r ? xcd * (q + 1) : r * (q + 1) + (xcd - r) * q) + off; }
        const int gid = wgid / nig, fm = gid * WGM, gsz = (NM - fm) < WGM ? (NM - fm) : WGM, w = wgid % nig, sh = 31 - __builtin_clz(gsz);
        pm = fm + (w & (gsz - 1)); pn = w >> sh; return true;
    }
};
template <int NM, int NN, int WG = 4> struct OrderFull {
    StaticOrderT<NM, NN, WG> so; int nt;
    __device__ bool next(int i, Unit& u) const { if (!so.tile(i, u.pm, u.pn)) return false; u.kofs = 0; u.nt = nt; u.br = 0; return true; }
    __device__ __forceinline__ void a_ready(const Unit&) const {}
    __device__ __forceinline__ void done(const Unit&) const {}
};
template <int NM, int NN, int WG = 4> struct OrderBranch {
    StaticOrderT<NM, NN, WG> so;
    __device__ bool next(int i, Unit& u) const {
        if (!so.tile(i >> 2, u.pm, u.pn)) return false; const int br = i & 3; u.br = br;
        u.kofs = br == 0 ? 0 : 256 + 256 * br; u.nt = br == 0 ? 8 : 4; return true; }
    __device__ __forceinline__ void a_ready(const Unit&) const {}
    __device__ __forceinline__ void done(const Unit&) const {}
};
template <class Epi, class Sched, bool ALIGN_EPI = false, bool SP2 = false>
__device__ __forceinline__ void gemm_phase(PG8_LAS unsigned char* lds, const Gemm g, const Sched& S, const Epi& E) {
    int tid_ = threadIdx.x; asm volatile("" : "+v"(tid_));
    const int tid = tid_, wid = __builtin_amdgcn_readfirstlane(tid >> 6), lane = tid & 63, wr = wid >> 2, wc = wid & 3, fr = lane & 15, fq = lane >> 4;
    const int K = g.ld;
    unsigned voffA[2], voffB[2];
#pragma unroll
    for (int i = 0; i < 2; ++i) { int R, C; stage_rc(tid * 16 + i * 8192, R, C); const int Rb = Epi::PERM ? ((R & ~31) + perm32(R & 31)) : R;
        voffA[i] = (unsigned)(R * K + C) * 2u; voffB[i] = (unsigned)(Rb * K + C) * 2u; }
    const size_t kstep = (size_t)(BK * 2);
    const size_t hstep = (size_t)HALF * K * 2;
    const size_t tstep = 2 * hstep;
    const unsigned ldsw = (unsigned)wid * 1024u;
    const int aoff = lds_byte(wr * 64 + fr, fq * 8), boff = lds_byte(wc * 32 + fr, fq * 8);
#define PG8_SA(b, h) (((b) * 2 + (h)) * HTB)
#define PG8_SB(b, h) ((4 + (b) * 2 + (h)) * HTB)
#define PG8_STAGE(bufoff, gbase, voff) do { _Pragma("unroll") for (int _i = 0; _i < 2; ++_i) \
        __builtin_amdgcn_global_load_lds((const unsigned*)((const char*)(gbase) + (voff)[_i]), (PG8_LAS unsigned*)(lds + (bufoff) + ldsw + _i * 8192), 16, 0, 0); } while (0)
#define PG8_LDA(dst, b, h) do { _Pragma("unroll") for (int m = 0; m < 4; ++m) _Pragma("unroll") for (int k = 0; k < 2; ++k) dst[m][k] = *(const PG8_LAS bf16x8*)(lds + PG8_SA(b, h) + aoff + m * 2048 + k * 1024); } while (0)
#define PG8_LDB(dst, b, h) do { _Pragma("unroll") for (int n = 0; n < 2; ++n) _Pragma("unroll") for (int k = 0; k < 2; ++k) dst[n][k] = *(const PG8_LAS bf16x8*)(lds + PG8_SB(b, h) + boff + n * 2048 + k * 1024); } while (0)
#define PG8_MMA(ai, bj, At, Bt) do { __builtin_amdgcn_s_setprio(1); _Pragma("unroll") for (int m = 0; m < 4; ++m) _Pragma("unroll") for (int n = 0; n < 2; ++n) _Pragma("unroll") for (int k = 0; k < 2; ++k) \
        acc[ai][bj][m][n] = __builtin_amdgcn_mfma_f32_16x16x32_bf16(Bt[n][k], At[m][k], acc[ai][bj][m][n], 0, 0, 0); __builtin_amdgcn_s_setprio(0); } while (0)
#define PG8_WAIT_V(n) asm volatile("s_waitcnt vmcnt(" #n ")" ::: "memory")
#define PG8_WAIT_L(n) asm volatile("s_waitcnt lgkmcnt(" #n ")" ::: "memory")
#define PG8_BAR __builtin_amdgcn_s_barrier()
#define PG8_SCHED __builtin_amdgcn_sched_barrier(0)
    Unit cur, nxt; int ui = 0;
    if (!S.next(0, cur)) return;
    f32x4 acc[2][2][4][2];
#pragma unroll
    for (int a = 0; a < 2; ++a)
#pragma unroll
        for (int b = 0; b < 2; ++b)
#pragma unroll
            for (int m = 0; m < 4; ++m)
#pragma unroll
                for (int n = 0; n < 2; ++n) acc[a][b][m][n] = (f32x4){0.f, 0.f, 0.f, 0.f};
    bf16x8 At[4][2], B0[2][2], B1[2][2];
    const char* cA = (const char*)g.A + (size_t)cur.pm * tstep + (size_t)cur.kofs * 2; const char* cB = (const char*)g.Bt + (size_t)cur.pn * tstep + (size_t)cur.kofs * 2;
    S.a_ready(cur);
    if constexpr (SP2) {
        PG8_STAGE(PG8_SB(0, 0), cB, voffB); PG8_STAGE(PG8_SB(0, 1), cB + hstep, voffB); PG8_STAGE(PG8_SA(0, 0), cA, voffA); PG8_STAGE(PG8_SA(0, 1), cA + hstep, voffA);
        if (wr == 1) PG8_BAR;
        PG8_WAIT_V(2); PG8_BAR;
        PG8_STAGE(PG8_SB(1, 0), cB + kstep, voffB); PG8_STAGE(PG8_SA(1, 0), cA + kstep, voffA); PG8_STAGE(PG8_SB(1, 1), cB + hstep + kstep, voffB);
        PG8_WAIT_V(6); PG8_BAR;
    } else {
        PG8_STAGE(PG8_SB(0, 0), cB, voffB); PG8_STAGE(PG8_SA(0, 0), cA, voffA); PG8_STAGE(PG8_SB(0, 1), cB + hstep, voffB); PG8_STAGE(PG8_SA(0, 1), cA + hstep, voffA);
        if (wr == 1) PG8_BAR;
        PG8_WAIT_V(4); PG8_BAR;
        PG8_STAGE(PG8_SB(1, 0), cB + kstep, voffB); PG8_STAGE(PG8_SA(1, 0), cA + kstep, voffA); PG8_STAGE(PG8_SB(1, 1), cB + hstep + kstep, voffB);
        PG8_WAIT_V(6); PG8_BAR;
    }
    for (;;) {
        const bool has_next = S.next(ui + 1, nxt);
        const char* nA = has_next ? (const char*)g.A + (size_t)nxt.pm * tstep + (size_t)nxt.kofs * 2 : cA; const char* nB = has_next ? (const char*)g.Bt + (size_t)nxt.pn * tstep + (size_t)nxt.kofs * 2 : cB;
        const int nt = cur.nt;
        for (int t = 0; t < nt; t += 2) {
            const bool last = (t == nt - 2);
            const char* a1 = cA + (size_t)(t + 1) * kstep;
            const char* a2 = last ? nA : cA + (size_t)(t + 2) * kstep; const char* b2 = last ? nB : cB + (size_t)(t + 2) * kstep;
            const char* a3 = a2 + kstep; const char* b3 = b2 + kstep;
            if (last && has_next) S.a_ready(nxt);
            if constexpr (SP2) {
            PG8_LDB(B0, 0, 0); PG8_LDB(B1, 0, 1); PG8_SCHED; PG8_LDA(At, 0, 0); PG8_STAGE(PG8_SA(1, 1), a1 + hstep, voffA);
            PG8_WAIT_V(8); PG8_WAIT_L(0); PG8_BAR; PG8_MMA(0, 0, At, B0); PG8_MMA(0, 1, At, B1); PG8_BAR; PG8_SCHED;
            PG8_LDA(At, 0, 1); PG8_STAGE(PG8_SB(0, 0), b2, voffB); PG8_STAGE(PG8_SB(0, 1), b2 + hstep, voffB); PG8_STAGE(PG8_SA(0, 0), a2, voffA);
            PG8_WAIT_V(8); PG8_WAIT_L(0); PG8_BAR; PG8_MMA(1, 0, At, B0); PG8_MMA(1, 1, At, B1); PG8_BAR; PG8_SCHED;
            PG8_LDB(B0, 1, 0); PG8_LDB(B1, 1, 1); PG8_SCHED; PG8_LDA(At, 1, 0); PG8_STAGE(PG8_SA(0, 1), a2 + hstep, voffA);
            PG8_WAIT_V(8); PG8_WAIT_L(0); PG8_BAR; PG8_MMA(0, 0, At, B0); PG8_MMA(0, 1, At, B1); PG8_BAR; PG8_SCHED;
            PG8_LDA(At, 1, 1); PG8_STAGE(PG8_SB(1, 0), b3, voffB); PG8_STAGE(PG8_SB(1, 1), b3 + hstep, voffB); PG8_STAGE(PG8_SA(1, 0), a3, voffA);
            PG8_WAIT_V(8); PG8_WAIT_L(0); PG8_BAR; PG8_MMA(1, 0, At, B0); PG8_MMA(1, 1, At, B1); PG8_BAR; PG8_SCHED;
            } else {
            PG8_LDB(B0, 0, 0); PG8_SCHED; PG8_LDA(At, 0, 0); PG8_STAGE(PG8_SA(1, 1), a1 + hstep, voffA);
            PG8_WAIT_L(8); PG8_BAR; PG8_WAIT_L(0); PG8_MMA(0, 0, At, B0); PG8_BAR; PG8_SCHED;
            PG8_LDB(B1, 0, 1); PG8_STAGE(PG8_SB(0, 0), b2, voffB);
            PG8_BAR; PG8_WAIT_L(0); PG8_MMA(0, 1, At, B1); PG8_BAR;
            PG8_LDA(At, 0, 1); PG8_STAGE(PG8_SA(0, 0), a2, voffA);
            PG8_BAR; PG8_WAIT_L(0); PG8_MMA(1, 0, At, B0); PG8_BAR; PG8_SCHED;
            PG8_STAGE(PG8_SB(0, 1), b2 + hstep, voffB);
            PG8_WAIT_V(6); PG8_BAR; PG8_MMA(1, 1, At, B1); PG8_BAR;
            PG8_LDB(B0, 1, 0); PG8_SCHED; PG8_LDA(At, 1, 0); PG8_STAGE(PG8_SA(0, 1), a2 + hstep, voffA);
            PG8_WAIT_L(8); PG8_BAR; PG8_WAIT_L(0); PG8_MMA(0, 0, At, B0); PG8_BAR; PG8_SCHED;
            PG8_LDB(B1, 1, 1); PG8_STAGE(PG8_SB(1, 0), b3, voffB);
            PG8_BAR; PG8_WAIT_L(0); PG8_MMA(0, 1, At, B1); PG8_BAR;
            PG8_LDA(At, 1, 1); PG8_STAGE(PG8_SA(1, 0), a3, voffA);
            PG8_BAR; PG8_WAIT_L(0); PG8_MMA(1, 0, At, B0); PG8_BAR; PG8_SCHED;
            PG8_STAGE(PG8_SB(1, 1), b3 + hstep, voffB);
            PG8_WAIT_V(6); PG8_BAR; PG8_MMA(1, 1, At, B1); PG8_BAR;
            }
        }
        if constexpr (ALIGN_EPI) { if (wr == 0) PG8_BAR; }
        if constexpr (!Epi::AFTER_DRAIN) { E(acc, cur, wr, wc, fr, fq); S.done(cur); }
        if (!has_next) break;
        if (!(Epi::KEEP && cur.br < 3))
#pragma unroll
        for (int a = 0; a < 2; ++a)
#pragma unroll
            for (int b = 0; b < 2; ++b)
#pragma unroll
                for (int m = 0; m < 4; ++m)
#pragma unroll
                    for (int n = 0; n < 2; ++n) acc[a][b][m][n] = (f32x4){0.f, 0.f, 0.f, 0.f};
        cur = nxt; cA = nA; cB = nB; ++ui;
        if constexpr (ALIGN_EPI) { if (wr == 1) PG8_BAR; }
    }
    PG8_WAIT_V(0);
    if constexpr (!ALIGN_EPI) { if (wr == 0) PG8_BAR; }
    PG8_BAR;
    if constexpr (Epi::AFTER_DRAIN) { E.fused(acc, cur, wr, wc, fr, fq, lds, wid, lane); S.done(cur); }
#undef PG8_SA
#undef PG8_SB
#undef PG8_STAGE
#undef PG8_LDA
#undef PG8_LDB
#undef PG8_MMA
#undef PG8_WAIT_V
#undef PG8_WAIT_L
#undef PG8_BAR
#undef PG8_SCHED
}
}
using pg8::Unit;

__device__ __forceinline__ unsigned pkq(float a, float b) { return pk2(a, b); }
__device__ __forceinline__ void st_wt16(void* base, size_t bytes, unsigned off, const u32x4 v) { __builtin_amdgcn_raw_buffer_store_b128(v, __builtin_amdgcn_make_buffer_rsrc(base, 0, (int)bytes, 0x00020000), off, 0, 16); }
struct EpiIn {
    static constexpr bool PERM = true, AFTER_DRAIN = false, KEEP = false;
    bf16_t* pxa; bf16_t* gates; const float* ropec; const float* ropes; int skip_st;
    __device__ __forceinline__ void operator()(const f32x4 (&acc)[2][2][4][2], const Unit& u, int wr, int wc, int fr, int fq) const {
        const int pn = u.pn, row0 = u.pm * 256 + wr * 64 + fr, colw = wc * 32 + 8 * fq;
        if (pn >= 16) {
            unsigned char* base = (unsigned char*)gates + ((pn - 16) * 16 + wc * 4 + fq) * 16;
#pragma unroll
            for (int ai = 0; ai < 2; ++ai)
#pragma unroll
                for (int m = 0; m < 4; ++m) { u32x4 w;
#pragma unroll
                    for (int br = 0; br < 4; ++br) { const f32x4 x = acc[ai][br >> 1][m][br & 1]; unsigned d = 0u;
#pragma unroll
                        for (int e = 0; e < 4; ++e) { const float g256 = __builtin_amdgcn_rcpf(fmaf(__builtin_amdgcn_exp2f(fminf(x[e] * -LOG2E, 86.f)), 1.f / 256.f, 1.f / 256.f));
                            d = __builtin_amdgcn_cvt_pk_u8_f32(fmaxf(g256, 1.f), e, d); }
                        w[br] = d; }
                    if (!skip_st) __builtin_nontemporal_store(w, (u32x4*)(base + (size_t)(row0 + ai * 128 + m * 16) * GW)); else asm volatile("" :: "v"(w)); }
        } else {
            const bool islat = u.pm < 64;
            const bool ropeall = (pn <= 1) || pn == 9 || pn == 10, rope0 = ropeall || pn == 2;
            const float sc = pn <= 1 ? QSCALE : (pn == 10 ? 0.125f : 1.f);
            const int axis = wc & 1;
            bf16_t* base = pxa + pn * 256 + colw;
#pragma unroll
            for (int ai = 0; ai < 2; ++ai)
#pragma unroll
                for (int m = 0; m < 4; ++m) { const int row = row0 + ai * 128 + m * 16; bf16_t* rowp = base + (size_t)row * PXW;
                    f32x4 c4 = {1.f, 1.f, 1.f, 1.f}, s4 = {0.f, 0.f, 0.f, 0.f};
                    if (rope0 && islat) { const int t = row & 4095, pos = axis ? (t & 63) : (t >> 6); c4 = *(const f32x4*)(ropec + pos * 16 + 4 * fq); s4 = *(const f32x4*)(ropes + pos * 16 + 4 * fq); }
#pragma unroll
                    for (int bj = 0; bj < 2; ++bj) { f32x4 v0 = acc[ai][bj][m][0], v1 = acc[ai][bj][m][1];
                        if ((bj == 0 ? rope0 : ropeall) && islat) { const f32x4 t1 = v0, t2 = v1; v0 = t1 * c4 - t2 * s4; v1 = t2 * c4 + t1 * s4; }
                        v0 = v0 * sc; v1 = v1 * sc; u32x4 w; w.x = pk2(v0[0], v0[1]); w.y = pk2(v0[2], v0[3]); w.z = pk2(v1[0], v1[1]); w.w = pk2(v1[2], v1[3]);
                        if (!skip_st) *(u32x4*)(rowp + bj * 128) = w; else asm volatile("" :: "v"(w)); } }
        }
    }
};
struct EpiWo {
    static constexpr bool PERM = true, AFTER_DRAIN = false, KEEP = true;
    const unsigned char* gates; bf16_t* tb;
    __device__ __forceinline__ void operator()(f32x4 (&acc)[2][2][4][2], const Unit& u, int wr, int wc, int fr, int fq) const {
        const int br = u.br, row0 = u.pm * 256 + wr * 64 + fr, col0 = u.pn * 256 + wc * 32 + 8 * fq;
#pragma unroll
        for (int ai = 0; ai < 2; ++ai)
#pragma unroll
            for (int m = 0; m < 4; ++m) { const size_t row = (size_t)(row0 + ai * 128 + m * 16);
#pragma unroll
                for (int bj = 0; bj < 2; ++bj) { const int col = col0 + bj * 128; const unsigned char* gp = gates + row * GW + (col >> 2) * 16 + br * 4;
                    f32x4 r[2];
#pragma unroll
                    for (int n = 0; n < 2; ++n) {
                        if (br < 3) { const u32x2 d = *(const u32x2*)(gp + n * 16);
#pragma unroll
                            for (int e = 0; e < 4; ++e) r[n][e] = (float)((d.x >> (8 * e)) & 0xffu) * __builtin_amdgcn_rcpf((float)((d.y >> (8 * e)) & 0xffu)); }
                        else { const unsigned d = *(const unsigned*)(gp + n * 16);
#pragma unroll
                            for (int e = 0; e < 4; ++e) r[n][e] = (float)((d >> (8 * e)) & 0xffu) * (1.f / 256.f); } }
                    const f32x4 v0 = acc[ai][bj][m][0] * r[0], v1 = acc[ai][bj][m][1] * r[1];
                    acc[ai][bj][m][0] = v0; acc[ai][bj][m][1] = v1;
                    if (br == 3) { u32x4 w; w.x = pk2(v0[0], v0[1]); w.y = pk2(v0[2], v0[3]); w.z = pk2(v1[0], v1[1]); w.w = pk2(v1[2], v1[3]); st_wt16(tb, (size_t)MROWS * D * 2, (unsigned)((row * D + col) * 2), w); } } }
    }
};
struct EpiOut {
    static constexpr bool PERM = true, AFTER_DRAIN = false, KEEP = false;
    bf16_t* out; float* ssp;
    __device__ __forceinline__ void operator()(const f32x4 (&acc)[2][2][4][2], const Unit& u, int wr, int wc, int fr, int fq) const {
        const int row0 = u.pm * 256 + wr * 64 + fr, col0 = u.pn * 256 + wc * 32 + 8 * fq;
#pragma unroll
        for (int ai = 0; ai < 2; ++ai)
#pragma unroll
            for (int m = 0; m < 4; ++m) { const size_t row = (size_t)(row0 + ai * 128 + m * 16); float ss = 0.f;
#pragma unroll
                for (int bj = 0; bj < 2; ++bj) { const f32x4 v0 = acc[ai][bj][m][0], v1 = acc[ai][bj][m][1];
                    u32x4 w; w.x = pk2(v0[0], v0[1]); w.y = pk2(v0[2], v0[3]); w.z = pk2(v1[0], v1[1]); w.w = pk2(v1[2], v1[3]); st_wt16(out, (size_t)MROWS * D * 2, (unsigned)((row * D + col0 + bj * 128) * 2), w);
                    ss += (v0[0] * v0[0] + v0[1] * v0[1]) + (v0[2] * v0[2] + v0[3] * v0[3]) + (v1[0] * v1[0] + v1[1] * v1[1]) + (v1[2] * v1[2] + v1[3] * v1[3]); }
                ss += __shfl_xor(ss, 16); ss += __shfl_xor(ss, 32);
                if (fq == 0) { float* sp = ssp + row * 32 + (u.pn * 4 + wc) * 2; sp[0] = ss; sp[1] = 0.f; } }
    }
};

#define GAS __attribute__((address_space(1)))
#define XB_TMO      128
#define XB_XCNT(j)  (256  + 64 * (j))
#define XB_XSUB(j)  (1280 + 64 * (j))
#define XB_XGEN(j)  (2304 + 64 * (j))
#define XB_TOP      3328
#define XB_TOPGEN   3392
#define XCD_BAR_WORDS 3456
#define XB_SPIN_CAP (1u << 18)

__device__ __forceinline__ unsigned xb_ld(unsigned* p)              { return __hip_atomic_load(p, __ATOMIC_RELAXED, __HIP_MEMORY_SCOPE_AGENT); }
__device__ __forceinline__ unsigned xb_add(unsigned* p, unsigned v) { return __hip_atomic_fetch_add(p, v, __ATOMIC_RELAXED, __HIP_MEMORY_SCOPE_AGENT); }
__device__ __forceinline__ unsigned xb_xcc_id() { return (unsigned)__builtin_amdgcn_s_getreg((3 << 11) | 20) & 0xFu; }
#define XB_SPIN(cond, bar) do { unsigned _sp = 0; while (cond) { __builtin_amdgcn_s_sleep(1); \
    if ((++_sp & 255u) == 0u) { if (xb_ld(&(bar)[XB_TMO])) break; if (_sp > XB_SPIN_CAP) { atomicAdd(&(bar)[XB_TMO], 1u); break; } } } } while (0)

struct XcdBarrier {
    unsigned* bar; unsigned x;
    volatile LAS unsigned* st;
};

__device__ __forceinline__ XcdBarrier xcd_barrier_post(unsigned* bar, volatile LAS unsigned* st) {
    XcdBarrier b; b.bar = bar; b.x = xb_xcc_id(); b.st = st;
    if (threadIdx.x == 0) (void)xb_add(&bar[XB_XCNT(b.x)], 1u);
    return b;
}
__device__ __forceinline__ void xcd_barrier_complete(unsigned* bar, unsigned x, unsigned& nloc, unsigned& nx) {
    const unsigned G = gridDim.x * gridDim.y * gridDim.z;
    unsigned sum, cnt, mine, sp = 0u;
    for (;;) {
        sum = 0u; cnt = 0u; mine = 0u;
#pragma unroll
        for (unsigned j = 0; j < 16; ++j) { const unsigned c = xb_ld(&bar[XB_XCNT(j)]); sum += c; cnt += (c > 0u) ? 1u : 0u; mine = (j == x) ? c : mine; }
        if (sum == G) break;
        __builtin_amdgcn_s_sleep(1);
        if ((++sp & 255u) == 0u) { if (xb_ld(&bar[XB_TMO])) break; if (sp > XB_SPIN_CAP) { atomicAdd(&bar[XB_TMO], 1u); break; } }
    }
    nloc = mine > 0u ? mine : 1u; nx = cnt > 0u ? cnt : 1u;
}

__device__ __forceinline__ void xcd_barrier(const XcdBarrier& b) {
    asm volatile("s_waitcnt vmcnt(0)" ::: "memory");
    __syncthreads();
    if (threadIdx.x == 0) {
        unsigned* bar = b.bar;
        __builtin_amdgcn_s_waitcnt(0);
        unsigned nloc = b.st[0], nx = b.st[1];
        if (nloc == 0u) { xcd_barrier_complete(bar, b.x, nloc, nx); b.st[0] = nloc; b.st[1] = nx; }
        const unsigned old = xb_add(&bar[XB_XSUB(b.x)], 1u);
        const unsigned gen = old / nloc;
        if (old + 1u == (gen + 1u) * nloc) {
            __builtin_amdgcn_fence(__ATOMIC_RELEASE, "agent");
            asm volatile("s_waitcnt vmcnt(0)" ::: "memory");
            const unsigned og = xb_add(&bar[XB_TOP], 1u);
            const unsigned tg = og / nx;
            if (og + 1u == (tg + 1u) * nx) xb_add(&bar[XB_TOPGEN], 1u);
            else XB_SPIN(xb_ld(&bar[XB_TOPGEN]) == tg, bar);
            __builtin_amdgcn_fence(__ATOMIC_ACQUIRE, "agent");
            xb_add(&bar[XB_XGEN(b.x)], 1u);
            asm volatile("s_waitcnt vmcnt(0)" ::: "memory");
        } else {
            XB_SPIN(xb_ld(&bar[XB_XGEN(b.x)]) == gen, bar);
            __builtin_amdgcn_fence(__ATOMIC_ACQUIRE, "agent");
            asm volatile("s_waitcnt vmcnt(0)" ::: "memory");
        }
    }
    __syncthreads();
}

struct F {
    LAS unsigned char* lds; int tid, lane, wave, bid, nb, gw, ngw;
};
__device__ __forceinline__ const float* xrow_in(const P& p, int l, int row) {
    if (l == 0) return row < LATROWS ? p.x + (size_t)row * D : p.ctx + (size_t)(row - LATROWS) * D;
    return row < LATROWS ? p.out + (size_t)row * D : (const float*)(p.ws + WS_XC) + (size_t)(row - LATROWS) * D;
}
__device__ __forceinline__ float* xrow_out(const P& p, int row) { return row < LATROWS ? p.out + (size_t)row * D : (float*)(p.ws + WS_XC) + (size_t)(row - LATROWS) * D; }
__device__ __forceinline__ const float* mod_row(const P& p, int l, int row) { const int src = row < LATROWS ? (row >> 12) : 4; return (const float*)(p.ws + WS_MOD) + ((size_t)l * 5 + src) * 3 * D; }

__device__ __forceinline__ void hx_row(const f32x4 (&v)[4], const float* g, const float* mod, bf16_t* orow, int lane) {
    float ss = 0.f;
#pragma unroll
    for (int j = 0; j < 4; ++j) ss += (v[j][0] * v[j][0] + v[j][1] * v[j][1]) + (v[j][2] * v[j][2] + v[j][3] * v[j][3]);
    const float rs = rsqrtf(wave_sum(ss) * (1.f / D) + EPS);
#pragma unroll
    for (int j = 0; j < 4; ++j) { const int col = 4 * lane + 256 * j; const f32x4 g4 = *(const f32x4*)(g + col), sh = *(const f32x4*)(mod + col), sc = *(const f32x4*)(mod + D + col);
        const f32x4 h = v[j] * rs * g4 * (sc + 1.f) + sh; u32x2 w; w.x = pk2(h[0], h[1]); w.y = pk2(h[2], h[3]); *(u32x2*)(orow + col) = w; }
}

__device__ __forceinline__ void ph_mod(const P& p, const F& f) {
    LAS float* sc = (LAS float*)f.lds;
    LAS float* red = (LAS float*)(f.lds + 20480);
    float* mod = (float*)(p.ws + WS_MOD);
    for (int i = f.tid; i < 5 * D; i += NTHR) sc[i] = siluf(i < 4 * D ? p.c[i] : p.cctx[i - 4 * D]);
    __syncthreads();
    for (int u = f.bid; u < 4 * 48; u += f.nb) {
        const int l = u / 48, col = (u % 48) * 64 + f.lane;
        const float* w = p.w_ada + (size_t)l * D * 3 * D + col;
        float acc[5] = {0.f, 0.f, 0.f, 0.f, 0.f};
#pragma unroll 1
        for (int k0 = 0; k0 < 128; k0 += 16) { float wv[16];
#pragma unroll
            for (int kk = 0; kk < 16; ++kk) wv[kk] = w[(size_t)(f.wave * 128 + k0 + kk) * 3 * D];
#pragma unroll
            for (int kk = 0; kk < 16; ++kk) { const int k = f.wave * 128 + k0 + kk;
#pragma unroll
                for (int s5 = 0; s5 < 5; ++s5) acc[s5] += sc[s5 * D + k] * wv[kk]; } }
#pragma unroll
        for (int s5 = 0; s5 < 5; ++s5) red[(f.wave * 5 + s5) * 64 + f.lane] = acc[s5];
        __syncthreads();
        if (f.wave < 5) { float t = 0.f;
#pragma unroll
            for (int w8 = 0; w8 < 8; ++w8) t += red[(w8 * 5 + f.wave) * 64 + f.lane];
            mod[((size_t)l * 5 + f.wave) * 3 * D + col] = t + p.b_ada[l * 3 * D + col]; }
        __syncthreads();
    }
}

__device__ __forceinline__ int sigma32(int q) { return 16 * ((q >> 2) & 1) + 4 * (q >> 3) + (q & 3); }
__device__ __forceinline__ void tr_item(const float* W, int N, bf16_t* WT, int ldo, int orow0, int koff, int k0, int scol0, int mode, LAS float* scr, int lane) {
    const int jq = lane & 7, j0 = 4 * jq, sc = scol0 + (mode == 0 ? j0 : (mode == 1 ? sigma32(j0) : ((j0 >> 2) & 1) * 1024 + 4 * (j0 >> 3)));
    f32x4 wv[8];
#pragma unroll
    for (int i = 0; i < 8; ++i) wv[i] = *(const f32x4*)(W + (size_t)(k0 + (lane >> 3) + 8 * i) * N + sc);
#pragma unroll
    for (int i = 0; i < 8; ++i) { LAS float* d = scr + ((lane >> 3) + 8 * i) * 33 + j0; d[0] = wv[i][0]; d[1] = wv[i][1]; d[2] = wv[i][2]; d[3] = wv[i][3]; }
    LDS_WAIT();
    const int c = lane & 7;
#pragma unroll
    for (int jj = 0; jj < 4; ++jj) { const int n = (lane >> 3) + 8 * jj; const LAS float* s = scr + (8 * c) * 33 + n;
        u32x4 o; o.x = pk2(s[0 * 33], s[1 * 33]); o.y = pk2(s[2 * 33], s[3 * 33]); o.z = pk2(s[4 * 33], s[5 * 33]); o.w = pk2(s[6 * 33], s[7 * 33]);
        *(u32x4*)(WT + (size_t)(orow0 + n) * ldo + koff + k0 + 8 * c) = o; }
    LDS_WAIT();
}
__device__ __forceinline__ void ff_item(const float* W, bf16_t* WT, int part, int g, int chalf, int kb, LAS float* scr, const LAS float* trig, int lane) {
#pragma unroll 1
    for (int hp = 0; hp < 2; ++hp) { const int k0 = 64 * kb + 32 * hp;
        { float wv[32];
#pragma unroll
            for (int kk = 0; kk < 32; ++kk) wv[kk] = W[(size_t)(k0 + kk) * INW + 3328 + g * 64 + lane];
#pragma unroll
            for (int kk = 0; kk < 32; ++kk) scr[kk * 65 + lane] = wv[kk]; }
        LDS_WAIT();
        const int c4 = lane & 3;
        for (int jj = 0; jj < 2; ++jj) { const int n = (lane >> 2) + 16 * jj, cp = chalf * 32 + n;
            float a[8] = {0.f, 0.f, 0.f, 0.f, 0.f, 0.f, 0.f, 0.f};
            for (int c = 0; c < 64; ++c) { const float tv = trig[part * 64 + ((c * cp) & 63)];
#pragma unroll
                for (int q = 0; q < 8; ++q) a[q] += scr[(8 * c4 + q) * 65 + c] * tv; }
            u32x4 o; o.x = pk2(a[0], a[1]); o.y = pk2(a[2], a[3]); o.z = pk2(a[4], a[5]); o.w = pk2(a[6], a[7]);
            *(u32x4*)(WT + (size_t)((part ? C_FS : C_FC) + g * 64 + cp) * D + k0 + 8 * c4) = o; }
        LDS_WAIT(); }
}
constexpr int NC_FF = 256, NC_WIN = 16 * 256, NC_WO = 20 * 32, NC_WOUT = 16 * 32, N_CONV_ITEMS = NC_FF + NC_WIN + NC_WO + NC_WOUT;
__device__ __forceinline__ void conv_item(const P& p, int l, int it, LAS float* scr, const LAS float* trig, int lane, int which = 0) {
    int r = it;
    { const bool reg = it >= NC_FF; if ((which == 1 && !reg) || (which == 2 && reg)) return; }
    if (r < NC_FF) { const int kb = r & 15, chalf = (r >> 4) & 1, g = (r >> 5) & 3, part = (r >> 7) & 1;
        ff_item(p.w_in + (size_t)l * D * INW, (bf16_t*)(p.ws + WS_WIN + l * WIN_L), part, g, chalf, kb, scr, trig, lane); return; }
    r -= NC_FF;
    if (r < NC_WIN) { const int nbk = r & 255, kb = (r >> 8) & 15, p0 = nbk * 32;
        if (p0 >= C_FC && p0 < C_FZ) return;
        int sbase, mode = 0;
        if (p0 < C_FC) { sbase = p0; mode = ((p0 < 640) || (p0 >= C_RQ && p0 < C_RV)) ? 1 : 0; }
        else if (p0 < 4096) sbase = 3584 + (p0 - C_FZ);
        else { const int pn = p0 >> 8, q0 = p0 & 255, bj = q0 >> 7, wcb = (q0 >> 5) & 3; sbase = 3840 + 2 * bj * 1024 + 64 * (pn - 16) + 16 * wcb; mode = 2; }
        tr_item(p.w_in + (size_t)l * D * INW, INW, (bf16_t*)(p.ws + WS_WIN + l * WIN_L), D, p0, 0, kb * 64, sbase, mode, scr, lane); return; }
    r -= NC_WIN;
    if (r < NC_WO) { const int nbk = r & 31, kbb = r >> 5;
        const int br = kbb < 8 ? 0 : 1 + (kbb - 8) / 4, kb = kbb < 8 ? kbb : (kbb - 8) % 4, koff = br == 0 ? 0 : 256 + 256 * br, Kb = br == 0 ? 512 : 256;
        tr_item(p.w_o[br] + (size_t)l * Kb * D, D, (bf16_t*)(p.ws + WS_WO + l * WO_L), YW, nbk * 32, koff, kb * 64, nbk * 32, 0, scr, lane); return; }
    r -= NC_WO;
    { const int nbk = r & 31, kb = r >> 5;
        tr_item(p.w_out + (size_t)l * D * D, D, (bf16_t*)(p.ws + WS_WOUT + l * WOUT_L), D, nbk * 32, 0, kb * 64, nbk * 32, 0, scr, lane); }
}
__device__ __forceinline__ void ph_prologue(const P& p, const F& f) {
    LAS float* scr = (LAS float*)(f.lds + f.wave * 8448);
    LAS float* trig = (LAS float*)(f.lds + 8 * 8448);
    if (f.tid < 64) { trig[f.tid] = cospif(f.tid / 32.f); trig[64 + f.tid] = sinpif(f.tid / 32.f); }
    __syncthreads();
    for (int it = f.gw; it < 4 * N_CONV_ITEMS + 3; it += f.ngw) {
        if (it < 4 * N_CONV_ITEMS) { conv_item(p, it & 3, it >> 2, scr, trig, f.lane, (it & 3) == 0 ? 0 : 2); continue; }
        if (it == 4 * N_CONV_ITEMS + 1 || it == 4 * N_CONV_ITEMS + 2) {
            const bool s1 = it == 4 * N_CONV_ITEMS + 1; bf16_t* dst = (bf16_t*)(p.ws + (s1 ? WS_FA1 : WS_FA2));
            for (int e = f.lane; e < (s1 ? 128 : 64) * 128; e += 64) { const int i = e >> 7, k = e & 127, ip = k >> 6, n1 = k & 63; float v;
                if (s1) { const int op = i >> 6, k1 = i & 63, ph = (k1 * n1) & 63; const float cv = cospif(ph / 32.f), sv = sinpif(ph / 32.f); v = op == 0 ? (ip == 0 ? cv : -sv) : (ip == 0 ? -sv : -cv); }
                else { const int ph = (i * n1) & 63; v = ip == 0 ? cospif(ph / 32.f) : sinpif(ph / 32.f); }
                dst[i * 136 + k] = (bf16_t)f2bf(v); }
            continue; }
        {
            float* rc = (float*)(p.ws + WS_ROPE); float* rsn = rc + 1024;
            for (int i = f.lane; i < 1024; i += 64) { const int pos = i >> 4, j = i & 15; const float inv = powf(10000.f, -(float)j / 16.f), ang = (float)pos * inv; rc[i] = cosf(ang); rsn[i] = sinf(ang); }
        }
    }
    for (int row = f.gw; row < MROWS; row += f.ngw) {
        const float* xr = xrow_in(p, 0, row); f32x4 v[4];
#pragma unroll
        for (int j = 0; j < 4; ++j) v[j] = *(const f32x4*)(xr + 4 * f.lane + 256 * j);
        hx_row(v, p.norm_pre, mod_row(p, 0, row), (bf16_t*)(p.ws + WS_HX) + (size_t)row * D, f.lane);
    }
}

__device__ __forceinline__ void ph_post(const P& p, const F& f, int l, int dry) {
    const bf16_t* outb = (const bf16_t*)(p.ws + WS_PXA); const float* ssp = (const float*)(p.ws + WS_SSP2);
    const int nrows = l < DEPTH - 1 ? MROWS : LATROWS;
    for (int row = f.gw; row < nrows; row += f.ngw) {
        const bf16_t* orow = outb + (size_t)row * D; const float* xr = xrow_in(p, l, row); float* xo = dry ? (float*)(p.ws + WS_INCR) + (size_t)(row & 8191) * D : xrow_out(p, row); const float* mod = mod_row(p, l, row);
        const float sp = f.lane < 32 ? ssp[(size_t)row * 32 + f.lane] : 0.f;
        const float rs = rsqrtf(wave_sum(sp) * (1.f / D) + EPS);
        f32x4 v[4], ov[4], xv[4];
#pragma unroll
        for (int j = 0; j < 4; ++j) { const int col = 4 * f.lane + 256 * j; const u32x2 ow = *(const u32x2*)(orow + col); ov[j] = (f32x4){bf2f(ow.x & 0xffffu), bf2f(ow.x >> 16), bf2f(ow.y & 0xffffu), bf2f(ow.y >> 16)}; xv[j] = __builtin_nontemporal_load((const f32x4*)(xr + col)); }
#pragma unroll
        for (int j = 0; j < 4; ++j) { const int col = 4 * f.lane + 256 * j; const f32x4 gt = *(const f32x4*)(mod + 2 * D + col), gp = *(const f32x4*)(p.norm_post + l * D + col); v[j] = xv[j] + gt * (ov[j] * rs * gp); }
#pragma unroll
        for (int j = 0; j < 4; ++j) __builtin_nontemporal_store(v[j], (f32x4*)(xo + 4 * f.lane + 256 * j));
        if (l < DEPTH - 1) hx_row(v, p.norm_pre + (l + 1) * D, mod_row(p, l + 1, row), (bf16_t*)(p.ws + (dry ? WS_Y : WS_HX)) + (size_t)row * D, f.lane);
    }
}

__device__ __forceinline__ void unpack8(const u32x4 w, float (&o)[8]) { o[0] = bf2f(w.x & 0xffffu); o[1] = bf2f(w.x >> 16); o[2] = bf2f(w.y & 0xffffu); o[3] = bf2f(w.y >> 16); o[4] = bf2f(w.z & 0xffffu); o[5] = bf2f(w.z >> 16); o[6] = bf2f(w.w & 0xffffu); o[7] = bf2f(w.w >> 16); }
__device__ __forceinline__ void conv_unit(const P& p, const F& f, int l, int u) {
    const bf16_t* pxa = (const bf16_t*)(p.ws + WS_PXA); bf16_t* Y = (bf16_t*)(p.ws + WS_Y);
    const float* cw = p.conv_w + l * 768; const float* cb = p.conv_b + l * 256;
    u32x4 ru1[4], rc1[4], rbb[4], rbz[4], ru0[4], rc0[4], ru2[4], rc2[4]; float m0[4], m2[4];
#pragma unroll
    for (int k_ = 0; k_ < 4; ++k_) { const long it = (long)u * 2048 + k_ * NTHR + f.tid; const int row = (int)(it >> 5), c0 = ((int)it & 31) * 8;
        const bool lat = row < LATROWS; const int t = lat ? (row & 4095) : ((row - LATROWS) & 255), n = lat ? S : L;
        const bool h0 = t > 0, h2 = t < n - 1; m0[k_] = h0 ? 1.f : 0.f; m2[k_] = h2 ? 1.f : 0.f;
        const bf16_t* r1 = pxa + (size_t)row * PXW + c0; const bf16_t* r0 = h0 ? r1 - PXW : r1; const bf16_t* r2 = h2 ? r1 + PXW : r1;
        ru1[k_] = *(const u32x4*)(r1 + C_BU); rc1[k_] = *(const u32x4*)(r1 + C_BC); rbb[k_] = *(const u32x4*)(r1 + C_BB); rbz[k_] = *(const u32x4*)(r1 + C_BZ);
        ru0[k_] = *(const u32x4*)(r0 + C_BU); rc0[k_] = *(const u32x4*)(r0 + C_BC); ru2[k_] = *(const u32x4*)(r2 + C_BU); rc2[k_] = *(const u32x4*)(r2 + C_BC); }
#pragma unroll
    for (int k_ = 0; k_ < 4; ++k_) { const long it = (long)u * 2048 + k_ * NTHR + f.tid; const int row = (int)(it >> 5), c0 = ((int)it & 31) * 8;
        float u1[8], c1[8], u0[8], c0v[8], u2[8], c2[8], bb[8], bz[8];
        unpack8(ru1[k_], u1); unpack8(rc1[k_], c1); unpack8(rbb[k_], bb); unpack8(rbz[k_], bz); unpack8(ru0[k_], u0); unpack8(rc0[k_], c0v); unpack8(ru2[k_], u2); unpack8(rc2[k_], c2);
        float o[8];
#pragma unroll
        for (int i = 0; i < 8; ++i) { const int c = c0 + i; const float a0 = m0[k_] * u0[i] * c0v[i], a1 = u1[i] * c1[i], a2 = m2[k_] * u2[i] * c2[i];
            o[i] = bb[i] * (a0 * cw[c] + a1 * cw[256 + c] + a2 * cw[512 + c] + cb[c]) * siluf(bz[i]); }
        u32x4 w; w.x = pk2(o[0], o[1]); w.y = pk2(o[2], o[3]); w.z = pk2(o[4], o[5]); w.w = pk2(o[6], o[7]);
        *(u32x4*)(Y + (size_t)row * YW + 512 + c0) = w; }
}

typedef short s16x4 __attribute__((ext_vector_type(4)));
__device__ __forceinline__ bf16x8 cat4(s16x4 a, s16x4 b) { return __builtin_shufflevector(a, b, 0, 1, 2, 3, 4, 5, 6, 7); }
#define MFMA16(a, b, c) __builtin_amdgcn_mfma_f32_16x16x32_bf16(a, b, c, 0, 0, 0)
__device__ __forceinline__ s16x4 ld_tr(const LAS unsigned char* q) { return __builtin_amdgcn_ds_read_tr16_b64_v4i16((LAS s16x4*)q); }
__device__ __forceinline__ bf16x8 frag_tr8(const LAS unsigned char* X, int pitch, int k0, int col0, int c, int g) {
    const LAS unsigned char* q = X + ((k0 + 8 * g + (c >> 2)) * pitch + col0 + 4 * (c & 3)) * 2; return cat4(ld_tr(q), ld_tr(q + 8 * pitch)); }
__device__ __forceinline__ bf16x8 frag_tr_pv(const LAS unsigned char* X, int pitch, int k0, int col0, int c, int g) {
    const LAS unsigned char* q = X + ((k0 + 4 * g + (c >> 2)) * pitch + col0 + 4 * (c & 3)) * 2; return cat4(ld_tr(q), ld_tr(q + 32 * pitch)); }
constexpr int KS_PITCH = 72, VS_PITCH = 80;
__device__ __forceinline__ float ex2(float x) { return __builtin_amdgcn_exp2f(x); }
__device__ __forceinline__ void swap16(float& a, float& b) { asm volatile("s_nop 1\n\tv_permlane16_swap_b32 %0, %1\n\ts_nop 1" : "+v"(a), "+v"(b)); }
__device__ __forceinline__ void swap32(float& a, float& b) { asm volatile("s_nop 1\n\tv_permlane32_swap_b32 %0, %1\n\ts_nop 1" : "+v"(a), "+v"(b)); }
__device__ __forceinline__ float rows_max(float x) { float a = x, b = x; swap16(a, b); float m = fmaxf(a, b), c = m; swap32(m, c); return fmaxf(m, c); }
__device__ __forceinline__ float rows_sum(float x) { float a = x, b = x; swap16(a, b); float m = a + b, c = m; swap32(m, c); return m + c; }

constexpr int ATT_BUF = 38912;
__device__ __forceinline__ int attn_next_tile(int ti, bool ctxq, int blk, int b, int& krow0, int& mtype) {
    for (; ti < 5; ++ti) {
        if (ti < 3) { if (ctxq) continue; const int kb = blk - 1 + ti; if (kb < 0 || kb > 31) continue; krow0 = b * S + kb * 128; mtype = ti == 0 ? 1 : (ti == 2 ? 2 : 0); return ti; }
        krow0 = LATROWS + b * L + (ti - 3) * 128; mtype = 0; return ti; }
    return 5;
}
__device__ __forceinline__ void attn_tile(const int MT, const LAS unsigned char* Ks, const LAS unsigned char* Vs, const bf16x8 (&qf)[4][2], f32x4 (&o)[4][4], float (&mrun)[4], f32x4 (&osum)[4], int th, int c, int g) {
    const u32x4 onesw = {0x3F803F80u, 0x3F803F80u, 0x3F803F80u, 0x3F803F80u}; const bf16x8 ones = __builtin_bit_cast(bf16x8, onesw);
#pragma unroll 1
    for (int sub = 0; sub < 4; ++sub) {
        f32x4 s[2][4];
#pragma unroll
        for (int kt = 0; kt < 2; ++kt) { const LAS unsigned char* kp = Ks + ((sub * 32 + kt * 16 + c) * KS_PITCH + 8 * g) * 2;
            const bf16x8 k0 = *(const LAS bf16x8*)kp, k1 = *(const LAS bf16x8*)(kp + 64);
#pragma unroll
            for (int qt = 0; qt < 4; ++qt) { const float nm = -mrun[qt]; f32x4 a = MFMA16(k0, qf[qt][0], ((f32x4){nm, nm, nm, nm})); s[kt][qt] = MFMA16(k1, qf[qt][1], a); } }
        if (MT != 0) {
            asm volatile("; masked tile" ::: "memory");
            const int sg = MT == 1 ? 1 : -1, dq = sg * (th * 64 + c - 4 * g - sub * 32);
#pragma unroll
            for (int kt = 0; kt < 2; ++kt)
#pragma unroll
                for (int qt = 0; qt < 4; ++qt)
#pragma unroll
                    for (int r = 0; r < 4; ++r) { const int e = sg * (kt * 16 + r - qt * 16); if (e < dq) s[kt][qt][r] = -INFINITY; }
        }
        bf16x8 pf[4];
#pragma unroll
        for (int qt = 0; qt < 4; ++qt) {
            float mx = fmaxf(fmaxf(fmaxf(s[0][qt][0], s[0][qt][1]), fmaxf(s[0][qt][2], s[0][qt][3])), fmaxf(fmaxf(s[1][qt][0], s[1][qt][1]), fmaxf(s[1][qt][2], s[1][qt][3])));
            mx = rows_max(mx);
            if (!__all(mx <= 0.f)) { const float d = fmaxf(mx, 0.f), alpha = ex2(-d); mrun[qt] += d; osum[qt] = osum[qt] * alpha;
#pragma unroll
                for (int r = 0; r < 4; ++r) { s[0][qt][r] -= d; s[1][qt][r] -= d; }
#pragma unroll
                for (int et = 0; et < 4; ++et) o[et][qt] = o[et][qt] * alpha; }
            f32x4 a, bq;
#pragma unroll
            for (int r = 0; r < 4; ++r) { a[r] = ex2(s[0][qt][r]); bq[r] = ex2(s[1][qt][r]); }
            u32x4 w; w.x = pk2(a[0], a[1]); w.y = pk2(a[2], a[3]); w.z = pk2(bq[0], bq[1]); w.w = pk2(bq[2], bq[3]); pf[qt] = __builtin_bit_cast(bf16x8, w);
            osum[qt] = MFMA16(ones, pf[qt], osum[qt]);
        }
#pragma unroll
        for (int et = 0; et < 4; ++et) { const bf16x8 vf = frag_tr_pv(Vs, VS_PITCH, sub * 32, et * 16, c, g);
#pragma unroll
            for (int qt = 0; qt < 4; ++qt) o[et][qt] = MFMA16(vf, pf[qt], o[et][qt]); }
    }
}
__device__ __forceinline__ void attn_unit(const P& p, const F& f, int l, bool ctxq, int b, int kvh, int blk) {
    const bf16_t* pxa = (const bf16_t*)(p.ws + WS_PXA); bf16_t* Y = (bf16_t*)(p.ws + WS_Y);
    const int c = f.lane & 15, g = f.lane >> 4, hg = f.wave >> 1, th = f.wave & 1, h = kvh * 4 + hg;
    const int qrow0 = (ctxq ? LATROWS + b * L + blk * 128 : b * S + blk * 128) + th * 64;
    bf16x8 qf[4][2];
#pragma unroll
    for (int qt = 0; qt < 4; ++qt)
#pragma unroll
        for (int ks = 0; ks < 2; ++ks) qf[qt][ks] = *(const bf16x8*)(pxa + (size_t)(qrow0 + qt * 16 + c) * PXW + C_AQ + h * 64 + ks * 32 + 8 * g);
    f32x4 o[4][4];
#pragma unroll
    for (int et = 0; et < 4; ++et)
#pragma unroll
        for (int qt = 0; qt < 4; ++qt) o[et][qt] = (f32x4){0.f, 0.f, 0.f, 0.f};
    float mrun[4]; f32x4 osum[4];
    const float sk = p.sink[l * 8 + h] * LOG2E, l0s = PROBE_ATT2 ? 2.f : 1.f;
#pragma unroll
    for (int qt = 0; qt < 4; ++qt) { mrun[qt] = sk; osum[qt] = (f32x4){l0s, l0s, l0s, l0s}; }
    const int skey = f.tid >> 3, sch = f.tid & 7;
    int krow0 = 0, mtype = 0; int ti = attn_next_tile(0, ctxq, blk, b, krow0, mtype);
    u32x4 kreg[2], vreg[2];
#pragma unroll
    for (int i = 0; i < 2; ++i) { const bf16_t* rp = pxa + (size_t)(krow0 + skey + 64 * i) * PXW + kvh * 64 + sch * 8; kreg[i] = *(const u32x4*)(rp + C_AK); vreg[i] = *(const u32x4*)(rp + C_AV); }
    int cur = 0;
    __syncthreads();
    while (ti < 5) {
        LAS unsigned char* Ks = f.lds + cur * ATT_BUF; LAS unsigned char* Vs = Ks + 18432;
#pragma unroll
        for (int i = 0; i < 2; ++i) { *(LAS u32x4*)(Ks + ((skey + 64 * i) * KS_PITCH + sch * 8) * 2) = kreg[i]; *(LAS u32x4*)(Vs + ((skey + 64 * i) * VS_PITCH + sch * 8) * 2) = vreg[i]; }
        __syncthreads();
        int krow0n = 0, mtn = 0; const int tn = attn_next_tile(ti + 1, ctxq, blk, b, krow0n, mtn);
        if (tn < 5) {
#pragma unroll
            for (int i = 0; i < 2; ++i) { const bf16_t* rp = pxa + (size_t)(krow0n + skey + 64 * i) * PXW + kvh * 64 + sch * 8; kreg[i] = *(const u32x4*)(rp + C_AK); vreg[i] = *(const u32x4*)(rp + C_AV); } }
        attn_tile(mtype, Ks, Vs, qf, o, mrun, osum, th, c, g);
#if PROBE_ATT2
        attn_tile(mtype, Ks, Vs, qf, o, mrun, osum, th, c, g);
#endif
        ti = tn; krow0 = krow0n; mtype = mtn; cur ^= 1;
    }
#pragma unroll 1
    for (int rep_ = 0; rep_ < 1 + PROBE_EPI; ++rep_) {
    asm volatile("" ::: "memory");
    u32x2 zw[4][4];
#pragma unroll
    for (int qt = 0; qt < 4; ++qt)
#pragma unroll
        for (int et = 0; et < 4; ++et) zw[qt][et] = *(const u32x2*)(pxa + (size_t)(qrow0 + qt * 16 + c) * PXW + C_AZ + h * 64 + et * 16 + 4 * g);
#pragma unroll
    for (int qt = 0; qt < 4; ++qt) {
        const float inv = 1.f / osum[qt][0]; const size_t row = (size_t)(qrow0 + qt * 16 + c);
#pragma unroll
        for (int et = 0; et < 4; ++et) { const int col = h * 64 + et * 16 + 4 * g; const u32x2 z2 = zw[qt][et];
            const f32x4 ov = o[et][qt] * inv; u32x2 w;
            w.x = pk2(ov[0] * siluf(bf2f(z2.x & 0xffffu)), ov[1] * siluf(bf2f(z2.x >> 16))); w.y = pk2(ov[2] * siluf(bf2f(z2.y & 0xffffu)), ov[3] * siluf(bf2f(z2.y >> 16)));
            *(u32x2*)(Y + row * YW + col) = w; }
    }
    }
}

__device__ __forceinline__ void unit_publish(const F& f, unsigned* cnt) {
    asm volatile("s_waitcnt vmcnt(0)" ::: "memory"); __syncthreads();
    if (f.tid == 0) __hip_atomic_fetch_add(cnt, 1u, __ATOMIC_RELAXED, __HIP_MEMORY_SCOPE_AGENT);
}
__device__ __forceinline__ void st_wt8(void* q, const u32x2 v) { __hip_atomic_store((unsigned long long*)q, (unsigned long long)v.x | ((unsigned long long)v.y << 32), __ATOMIC_RELAXED, __HIP_MEMORY_SCOPE_AGENT); }
__device__ __forceinline__ void st_wt4(float* q, float v) { __hip_atomic_store((unsigned*)q, __builtin_bit_cast(unsigned, v), __ATOMIC_RELAXED, __HIP_MEMORY_SCOPE_AGENT); }
__device__ __forceinline__ void unit_poll(const F& f, unsigned* cnt, unsigned want) {
    if (f.tid == 0) { unsigned spins = 0; while (__hip_atomic_load(cnt, __ATOMIC_RELAXED, __HIP_MEMORY_SCOPE_AGENT) < want && ++spins < (1u << 22)) __builtin_amdgcn_s_sleep(2); }
    __syncthreads();
}
__device__ __forceinline__ void unit_wait(const F& f, unsigned* cnt, unsigned want) {
    if (f.tid == 0) { unsigned spins = 0;
        while (__hip_atomic_load(cnt, __ATOMIC_RELAXED, __HIP_MEMORY_SCOPE_AGENT) < want && ++spins < (1u << 22)) __builtin_amdgcn_s_sleep(2);
        __builtin_amdgcn_fence(__ATOMIC_ACQUIRE, "agent"); asm volatile("s_waitcnt vmcnt(0)" ::: "memory"); }
    __syncthreads();
}

__device__ __forceinline__ float lg2_gamma(const P& p, int l, int dir, int h) { const float dec = p.ret_decay[l * 8 + dir * 4 + h]; return -log1pf(expf(-dec)) * LOG2E; }
__device__ __forceinline__ void chunk_rows(int u, int& b, int& h, int& g, int& rows0) { g = u % 34; const int bh = u / 34; b = bh >> 2; h = bh & 3; rows0 = g < 2 ? LATROWS + b * L + g * 128 : b * S + (g - 2) * 128; }
__device__ __forceinline__ u32x4 scale8(const u32x4 v, float sc) { u32x4 w; w.x = pk2(bf2f(v.x & 0xffffu) * sc, bf2f(v.x >> 16) * sc); w.y = pk2(bf2f(v.y & 0xffffu) * sc, bf2f(v.y >> 16) * sc);
    w.z = pk2(bf2f(v.z & 0xffffu) * sc, bf2f(v.z >> 16) * sc); w.w = pk2(bf2f(v.w & 0xffffu) * sc, bf2f(v.w >> 16) * sc); return w; }
__device__ __forceinline__ void ret1_unit(const P& p, const F& f, int l, int u) {
    const bf16_t* pxa = (const bf16_t*)(p.ws + WS_PXA); float* incr = (float*)(p.ws + WS_INCR);
    LAS unsigned char* Kz = f.lds; LAS unsigned char* Vs = f.lds + 40960;
    const int c = f.lane & 15, g4 = f.lane >> 4;
    {
        int b, h, g, rows0; chunk_rows(u, b, h, g, rows0);
        const float l0 = lg2_gamma(p, l, 0, h), l1 = lg2_gamma(p, l, 1, h);
        __syncthreads();
#pragma unroll
        for (int i = 0; i < 2; ++i) { const int idx = f.tid + i * NTHR, m = idx >> 3, ch = idx & 7; const bf16_t* rp = pxa + (size_t)(rows0 + m) * PXW + h * 64 + ch * 8;
            const u32x4 kv = *(const u32x4*)(rp + C_RK), vv = *(const u32x4*)(rp + C_RV);
            *(LAS u32x4*)(Kz + (m * VS_PITCH + ch * 8) * 2) = scale8(kv, ex2(l0 * (float)(127 - m)));
            *(LAS u32x4*)(Kz + ((128 + m) * VS_PITCH + ch * 8) * 2) = scale8(kv, ex2(l1 * (float)m));
            *(LAS u32x4*)(Vs + (m * VS_PITCH + ch * 8) * 2) = vv; }
        __syncthreads();
        const int dir = f.wave >> 2, et = f.wave & 3;
        f32x4 acc[4];
#pragma unroll
        for (int dt = 0; dt < 4; ++dt) acc[dt] = (f32x4){0.f, 0.f, 0.f, 0.f};
#pragma unroll
        for (int ks = 0; ks < 4; ++ks) { const bf16x8 vf = frag_tr8(Vs, VS_PITCH, ks * 32, et * 16, c, g4);
#pragma unroll
            for (int dt = 0; dt < 4; ++dt) { const bf16x8 kf = frag_tr8(Kz + dir * 20480, VS_PITCH, ks * 32, dt * 16, c, g4); acc[dt] = MFMA16(vf, kf, acc[dt]); } }
        float* op = incr + ((size_t)(((b * 4 + h) * 34 + g) * 2 + dir)) * 4096;
#pragma unroll
        for (int dt = 0; dt < 4; ++dt)
#pragma unroll
            for (int r = 0; r < 4; ++r) st_wt4(op + (et * 16 + 4 * g4 + r) * 64 + dt * 16 + c, acc[dt][r]);
        unit_publish(f, (unsigned*)(p.ws + WS_CTL) + CW_RC + (l * 16 + b * 4 + h) * 16);
    }
}
__device__ __forceinline__ void scan_unit(const P& p, const F& f, int l, int u) {
    const int half = u & 1, dir = (u >> 1) & 1, bh = u >> 2;
    const float* incr = (const float*)(p.ws + WS_INCR) + ((size_t)(bh * 34) * 2 + dir) * 4096; bf16_t* st = (bf16_t*)(p.ws + WS_STATE) + ((size_t)(bh * 34) * 2 + dir) * 4096;
    unit_wait(f, (unsigned*)(p.ws + WS_CTL) + CW_RC + (l * 16 + bh) * 16, 34u);
    const float G = ex2(lg2_gamma(p, l, dir, bh & 3) * 128.f);
    const int eo = (half * 32 + (f.tid >> 4)) * 64 + (f.tid & 15) * 4;
    f32x4 R = {0.f, 0.f, 0.f, 0.f};
#pragma unroll 1
    for (int j0 = 0; j0 < 34; j0 += 17) { f32x4 v[17];
#pragma unroll
        for (int j = 0; j < 17; ++j) { const int jj = j0 + j, gp = dir == 0 ? jj : (jj < 2 ? 1 - jj : 35 - jj); v[j] = *(const f32x4*)(incr + (size_t)gp * 8192 + eo); }
#pragma unroll
        for (int j = 0; j < 17; ++j) { const int jj = j0 + j, gp = dir == 0 ? jj : (jj < 2 ? 1 - jj : 35 - jj);
            u32x2 w; w.x = pk2(R[0], R[1]); w.y = pk2(R[2], R[3]); st_wt8(st + (size_t)gp * 8192 + eo, w); R = R * G + v[j]; } }
    unit_publish(f, (unsigned*)(p.ws + WS_CTL) + CW_SC + (l * 16 + bh) * 16);
}
__device__ __forceinline__ void ret2_unit(const P& p, const F& f, int l, int u) {
    const bf16_t* pxa = (const bf16_t*)(p.ws + WS_PXA); const bf16_t* stt = (const bf16_t*)(p.ws + WS_STATE); bf16_t* Y = (bf16_t*)(p.ws + WS_Y);
    LAS unsigned char* RT = f.lds; LAS unsigned char* Qx = f.lds + 18432; LAS unsigned char* Ks = f.lds + 55296; LAS unsigned char* Vs = f.lds + 73728;
    const int c = f.lane & 15, g4 = f.lane >> 4;
    {
        int b, h, g, rows0; chunk_rows(u, b, h, g, rows0);
        const float l0 = lg2_gamma(p, l, 0, h), l1 = lg2_gamma(p, l, 1, h);
        unit_poll(f, (unsigned*)(p.ws + WS_CTL) + CW_SC + (l * 16 + b * 4 + h) * 16, 4u);
#pragma unroll
        for (int i = 0; i < 2; ++i) { const int idx = f.tid + i * NTHR, dir = idx >> 9, e = (idx >> 3) & 63, d8 = (idx & 7) * 8;
            const unsigned long long* sp = (const unsigned long long*)(stt + ((size_t)(((b * 4 + h) * 34 + g) * 2 + dir)) * 4096 + e * 64 + d8);
            const unsigned long long lo = __hip_atomic_load(sp, __ATOMIC_RELAXED, __HIP_MEMORY_SCOPE_AGENT), hi2 = __hip_atomic_load(sp + 1, __ATOMIC_RELAXED, __HIP_MEMORY_SCOPE_AGENT);
            u32x4 w; w.x = (unsigned)lo; w.y = (unsigned)(lo >> 32); w.z = (unsigned)hi2; w.w = (unsigned)(hi2 >> 32); *(LAS u32x4*)(RT + ((dir * 64 + e) * KS_PITCH + d8) * 2) = w; }
#pragma unroll
        for (int i = 0; i < 2; ++i) { const int idx = f.tid + i * NTHR, m = idx >> 3, ch = idx & 7; const bf16_t* rp = pxa + (size_t)(rows0 + m) * PXW + h * 64 + ch * 8;
            const u32x4 qv = *(const u32x4*)(rp + C_RQ), kv = *(const u32x4*)(rp + C_RK), vv = *(const u32x4*)(rp + C_RV);
            *(LAS u32x4*)(Ks + (m * KS_PITCH + ch * 8) * 2) = kv;
            *(LAS u32x4*)(Qx + (m * KS_PITCH + ch * 8) * 2) = scale8(qv, ex2(l0 * (float)(m + 1)));
            *(LAS u32x4*)(Qx + ((128 + m) * KS_PITCH + ch * 8) * 2) = scale8(qv, ex2(l1 * (float)(128 - m)));
            *(LAS u32x4*)(Vs + (m * VS_PITCH + ch * 8) * 2) = vv; }
        u32x2 zq[4];
#pragma unroll
        for (int et = 0; et < 4; ++et) zq[et] = *(const u32x2*)(pxa + (size_t)(rows0 + f.wave * 16 + c) * PXW + C_RZ + h * 64 + et * 16 + 4 * g4);
        __syncthreads();
        const int ct = f.wave;
        f32x4 s[8];
#pragma unroll
        for (int mt = 0; mt < 8; ++mt) s[mt] = (f32x4){0.f, 0.f, 0.f, 0.f};
#pragma unroll
        for (int ks = 0; ks < 2; ++ks) { const bf16x8 qf = *(const LAS bf16x8*)(Qx + ((ct * 16 + c) * KS_PITCH + ks * 32 + 8 * g4) * 2);
#pragma unroll
            for (int mt = 0; mt < 8; ++mt) { const bf16x8 kf = *(const LAS bf16x8*)(Ks + ((mt * 16 + c) * KS_PITCH + ks * 32 + 8 * g4) * 2); s[mt] = MFMA16(kf, qf, s[mt]); } }
        const int cidx = ct * 16 + c; const float ixi = ex2(-l0 * (float)(cidx + 1));
#pragma unroll
        for (int mt = 0; mt < 8; ++mt)
#pragma unroll
            for (int r = 0; r < 4; ++r) { const int dd = cidx - (mt * 16 + 4 * g4 + r);
                const float dm = (dd >= 0 ? ex2(l0 * (float)dd) : 0.f) + (dd <= 0 ? ex2(-l1 * (float)dd) : 0.f); s[mt][r] *= dm * ixi; }
        f32x4 o[4];
#pragma unroll
        for (int et = 0; et < 4; ++et) o[et] = (f32x4){0.f, 0.f, 0.f, 0.f};
#pragma unroll
        for (int kb = 0; kb < 4; ++kb) { const f32x4 a = s[2 * kb], bq = s[2 * kb + 1]; u32x4 w; w.x = pk2(a[0], a[1]); w.y = pk2(a[2], a[3]); w.z = pk2(bq[0], bq[1]); w.w = pk2(bq[2], bq[3]);
            const bf16x8 pf = __builtin_bit_cast(bf16x8, w);
#pragma unroll
            for (int et = 0; et < 4; ++et) o[et] = MFMA16(frag_tr_pv(Vs, VS_PITCH, kb * 32, et * 16, c, g4), pf, o[et]); }
#pragma unroll
        for (int dir = 0; dir < 2; ++dir)
#pragma unroll
            for (int ks = 0; ks < 2; ++ks) { const bf16x8 qxf = *(const LAS bf16x8*)(Qx + ((dir * 128 + ct * 16 + c) * KS_PITCH + ks * 32 + 8 * g4) * 2);
#pragma unroll
                for (int et = 0; et < 4; ++et) { const bf16x8 rf = *(const LAS bf16x8*)(RT + ((dir * 64 + et * 16 + c) * KS_PITCH + ks * 32 + 8 * g4) * 2); o[et] = MFMA16(rf, qxf, o[et]); } }
        float sm = 0.f;
#pragma unroll
        for (int et = 0; et < 4; ++et) sm += (o[et][0] + o[et][1]) + (o[et][2] + o[et][3]);
        sm = rows_sum(sm);
        const float mu = sm * (1.f / 64.f); float q = 0.f;
#pragma unroll
        for (int et = 0; et < 4; ++et) { o[et] = o[et] - mu; q += (o[et][0] * o[et][0] + o[et][1] * o[et][1]) + (o[et][2] * o[et][2] + o[et][3] * o[et][3]); }
        q = rows_sum(q);
        const float rs = rsqrtf(q * (1.f / 64.f) + EPS); const size_t row = (size_t)(rows0 + cidx);
#pragma unroll
        for (int et = 0; et < 4; ++et) { const int col = h * 64 + et * 16 + 4 * g4; const u32x2 zw = zq[et]; const f32x4 ov = o[et] * rs; u32x2 w;
            w.x = pk2(ov[0] * siluf(bf2f(zw.x & 0xffffu)), ov[1] * siluf(bf2f(zw.x >> 16))); w.y = pk2(ov[2] * siluf(bf2f(zw.y & 0xffffu)), ov[3] * siluf(bf2f(zw.y >> 16)));
            *(u32x2*)(Y + row * YW + 768 + col) = w; }
    }
}

constexpr int FX_PITCH = 272, FA_PITCH = 136, LDS_TRIG = 161232, LDS_FA = 126416, LDS_FA2 = 109008, LDS_FC = 77824;
template <class RowPtr> __device__ __forceinline__ void fft_stage(const F& f, RowPtr rp) {
#pragma unroll
    for (int i = 0; i < 8; ++i) { const int idx = f.tid + i * NTHR, kr = idx >> 5, chunk = idx & 31; *(LAS u32x4*)(f.lds + (kr * FX_PITCH + chunk * 8) * 2) = *(const u32x4*)(rp(kr) + chunk * 8); }
}
template <int MT> __device__ __forceinline__ void fft_mma(const F& f, const int LDS_A, f32x4 (&acc)[2][MT]) {
    const int c = f.lane & 15, g4 = f.lane >> 4;
#pragma unroll
    for (int ks = 0; ks < 4; ++ks) { bf16x8 bf[2];
#pragma unroll
        for (int nt = 0; nt < 2; ++nt) bf[nt] = frag_tr8(f.lds, FX_PITCH, ks * 32, f.wave * 32 + nt * 16, c, g4);
#pragma unroll
        for (int mt = 0; mt < MT; ++mt) { const bf16x8 af = *(const LAS bf16x8*)(f.lds + LDS_A + ((mt * 16 + c) * FA_PITCH + ks * 32 + 8 * g4) * 2);
#pragma unroll
            for (int nt = 0; nt < 2; ++nt) acc[nt][mt] = MFMA16(bf[nt], af, acc[nt][mt]); } }
}
__device__ __forceinline__ void fft_trig(const F& f) {
    LAS float* tg = (LAS float*)(f.lds + LDS_TRIG);
    if (f.tid < 64) { tg[f.tid] = cospif(f.tid / 32.f); tg[64 + f.tid] = sinpif(f.tid / 32.f); }
    if (f.tid < 256) { tg[128 + f.tid] = cospif(f.tid / 128.f); tg[384 + f.tid] = sinpif(f.tid / 128.f); }
}
__device__ __forceinline__ void fft1_setup(const P& p, const F& f) {
    __syncthreads(); fft_trig(f);
    for (int e = f.tid; e < 34816 / 16; e += NTHR) *(LAS u32x4*)(f.lds + LDS_FA + e * 16) = *(const u32x4*)(p.ws + WS_FA1 + e * 16);
    __syncthreads();
}
__device__ __forceinline__ void fft1_unit(const P& p, const F& f, int l, int u) {
    const bf16_t* pxa = (const bf16_t*)(p.ws + WS_PXA); bf16_t* GP = (bf16_t*)(p.ws + WS_GP);
    const int c = f.lane & 15, g4 = f.lane >> 4;
    { const int b = u >> 6, n2 = u & 63;
        __syncthreads();
        fft_stage(f, [&](int kr) { return pxa + (size_t)(b * S + 64 * (kr & 63) + n2) * PXW + ((kr >> 6) ? C_FS : C_FC); });
        __syncthreads();
        f32x4 acc[2][8];
#pragma unroll
        for (int nt = 0; nt < 2; ++nt)
#pragma unroll
            for (int mt = 0; mt < 8; ++mt) acc[nt][mt] = (f32x4){0.f, 0.f, 0.f, 0.f};
        fft_mma<8>(f, LDS_FA, acc);
#pragma unroll
        for (int mt = 0; mt < 4; ++mt) { const int k1 = mt * 16 + c; const float ang = (float)(n2 * k1) * (1.f / 2048.f), cw = cospif(ang), sw = sinpif(ang);
#pragma unroll
            for (int nt = 0; nt < 2; ++nt) { const f32x4 gr = acc[nt][mt], gi = acc[nt][mt + 4], pr = gr * cw + gi * sw, pi = gi * cw - gr * sw;
                bf16_t* op = GP + ((size_t)((b * 64 + k1) * 2) * 64 + n2) * 256 + f.wave * 32 + nt * 16 + 4 * g4;
                u32x2 w; w.x = pk2(pr[0], pr[1]); w.y = pk2(pr[2], pr[3]); st_wt8(op, w);
                w.x = pk2(pi[0], pi[1]); w.y = pk2(pi[2], pi[3]); st_wt8(op + 64 * 256, w); } }
        unit_publish(f, (unsigned*)(p.ws + WS_CTL) + CW_F1 + (l * 4 + b) * 16);
    }
}
__device__ __forceinline__ void fft2_setup(const P& p, const F& f) {
    __syncthreads(); fft_trig(f);
    for (int e = f.tid; e < 17408 / 16; e += NTHR) *(LAS u32x4*)(f.lds + LDS_FA2 + e * 16) = *(const u32x4*)(p.ws + WS_FA2 + e * 16);
    __syncthreads();
}
__device__ __forceinline__ void fft2_unit(const P& p, const F& f, int l, int u) {
    const bf16_t* pxa = (const bf16_t*)(p.ws + WS_PXA); const bf16_t* GP = (const bf16_t*)(p.ws + WS_GP); bf16_t* Y = (bf16_t*)(p.ws + WS_Y);
    const int c = f.lane & 15, g4 = f.lane >> 4;
    { const int b = u >> 6, k1 = u & 63;
        unit_wait(f, (unsigned*)(p.ws + WS_CTL) + CW_F1 + (l * 4 + b) * 16, 64u);
        fft_stage(f, [&](int kr) { return GP + ((size_t)(b * 64 + k1) * 128 + kr) * 256; });
        __syncthreads();
        f32x4 acc[2][4];
#pragma unroll
        for (int nt = 0; nt < 2; ++nt)
#pragma unroll
            for (int mt = 0; mt < 4; ++mt) acc[nt][mt] = (f32x4){0.f, 0.f, 0.f, 0.f};
        fft_mma<4>(f, LDS_FA2, acc);
        u32x2 zq[4][2];
#pragma unroll
        for (int mt = 0; mt < 4; ++mt)
#pragma unroll
            for (int nt = 0; nt < 2; ++nt) zq[mt][nt] = *(const u32x2*)(pxa + (size_t)(b * S + 64 * (mt * 16 + c) + k1) * PXW + C_FZ + f.wave * 32 + nt * 16 + 4 * g4);
#pragma unroll
        for (int mt = 0; mt < 4; ++mt) { const size_t row = (size_t)(b * S + 64 * (mt * 16 + c) + k1);
#pragma unroll
            for (int nt = 0; nt < 2; ++nt) { const int ch = f.wave * 32 + nt * 16 + 4 * g4; const u32x2 zw = zq[mt][nt]; const f32x4 ov = acc[nt][mt] * (1.f / 512.f); u32x2 w;
                w.x = pk2(ov[0] * siluf(bf2f(zw.x & 0xffffu)), ov[1] * siluf(bf2f(zw.x >> 16))); w.y = pk2(ov[2] * siluf(bf2f(zw.y & 0xffffu)), ov[3] * siluf(bf2f(zw.y >> 16)));
                *(u32x2*)(Y + row * YW + 1024 + ch) = w; } }
    }
}
__device__ __forceinline__ void fctx_unit(const P& p, const F& f, int u) {
    const bf16_t* pxa = (const bf16_t*)(p.ws + WS_PXA); bf16_t* Y = (bf16_t*)(p.ws + WS_Y);
    LAS bf16_t* As = (LAS bf16_t*)(f.lds + LDS_FC); const LAS float* tg = (const LAS float*)(f.lds + LDS_TRIG);
    const int c = f.lane & 15, g4 = f.lane >> 4;
    { const int b = u >> 4, kb = u & 15;
        f32x4 acc[2][1];
        acc[0][0] = (f32x4){0.f, 0.f, 0.f, 0.f}; acc[1][0] = acc[0][0];
        for (int pass = 0; pass < 4; ++pass) {
            __syncthreads();
            for (int e = f.tid; e < 16 * 128; e += NTHR) { const int ko = e >> 7, k = e & 127, ip = k >> 6, n = pass * 64 + (k & 63), ph = ((kb * 16 + ko) * n) & 255;
                As[ko * FA_PITCH + k] = (bf16_t)f2bf(ip == 0 ? tg[128 + ph] : -tg[384 + ph]); }
            fft_stage(f, [&](int kr) { return pxa + (size_t)(LATROWS + b * L + pass * 64 + (kr & 63)) * PXW + ((kr >> 6) ? C_FS : C_FC); });
            __syncthreads();
            fft_mma<1>(f, LDS_FC, acc);
        }
        const size_t row = (size_t)(LATROWS + b * L + kb * 16 + c);
#pragma unroll
        for (int nt = 0; nt < 2; ++nt) { const int ch = f.wave * 32 + nt * 16 + 4 * g4; const u32x2 zw = *(const u32x2*)(pxa + row * PXW + C_FZ + ch); const f32x4 ov = acc[nt][0] * (1.f / 128.f); u32x2 w;
            w.x = pk2(ov[0] * siluf(bf2f(zw.x & 0xffffu)), ov[1] * siluf(bf2f(zw.x >> 16))); w.y = pk2(ov[2] * siluf(bf2f(zw.y & 0xffffu)), ov[3] * siluf(bf2f(zw.y >> 16)));
            *(u32x2*)(Y + row * YW + 1024 + ch) = w; }
    }
}


template <int MODE> __device__ __forceinline__ void gemm64_unit(const P& p, const F& f, const bf16_t* A, const bf16_t* Bt, int ld, int K, int row0, int col0) {
    constexpr int GP_ = 136;
    const int c = f.lane & 15, g4 = f.lane >> 4, m0 = (f.wave & 3) * 16, n0 = (f.wave >> 2) * 32;
    const int sr = f.tid >> 4, sc = (f.tid & 15) * 8;
    const bf16_t* ap = A + (size_t)(row0 + sr) * ld + sc; const bf16_t* bp = Bt + (size_t)(col0 + sr) * ld + sc;
    u32x4 ra[2][2], rb[2][2];
    const int nch = K >> 7;
#pragma unroll
    for (int q2 = 0; q2 < 2; ++q2)
#pragma unroll
        for (int i = 0; i < 2; ++i) { ra[q2][i] = *(const u32x4*)(ap + (size_t)(32 * i) * ld + q2 * 128); rb[q2][i] = *(const u32x4*)(bp + (size_t)(32 * i) * ld + q2 * 128); }
    f32x4 acc[2] = {{0.f, 0.f, 0.f, 0.f}, {0.f, 0.f, 0.f, 0.f}};
    __syncthreads();
    for (int kc0 = 0; kc0 < nch; kc0 += 2) {
#pragma unroll
        for (int q2 = 0; q2 < 2; ++q2) { const int kc = kc0 + q2;
            LAS unsigned char* As = f.lds + q2 * 34816; LAS unsigned char* Bs = As + 17408;
#pragma unroll
            for (int i = 0; i < 2; ++i) { *(LAS u32x4*)(As + ((sr + 32 * i) * GP_ + sc) * 2) = ra[q2][i]; *(LAS u32x4*)(Bs + ((sr + 32 * i) * GP_ + sc) * 2) = rb[q2][i]; }
            __syncthreads();
            if (kc + 2 < nch) {
#pragma unroll
                for (int i = 0; i < 2; ++i) { ra[q2][i] = *(const u32x4*)(ap + (size_t)(32 * i) * ld + (kc + 2) * 128); rb[q2][i] = *(const u32x4*)(bp + (size_t)(32 * i) * ld + (kc + 2) * 128); } }
#pragma unroll
            for (int ks = 0; ks < 4; ++ks) { const bf16x8 af = *(const LAS bf16x8*)(As + ((m0 + c) * GP_ + ks * 32 + 8 * g4) * 2);
#pragma unroll
                for (int nt = 0; nt < 2; ++nt) { const bf16x8 bf = *(const LAS bf16x8*)(Bs + ((n0 + nt * 16 + c) * GP_ + ks * 32 + 8 * g4) * 2); acc[nt] = MFMA16(bf, af, acc[nt]); } }
            if (MODE == 0 && kc >= 3 && (kc & 1)) {
                const int br = (kc - 3) >> 1; const unsigned char* gp = (const unsigned char*)(p.ws + WS_GATES) + (size_t)(row0 + m0 + c) * GW + ((col0 + n0 + 4 * g4) >> 2) * 16 + br * 4;
#pragma unroll
                for (int nt = 0; nt < 2; ++nt) { f32x4 r;
                    if (br < 3) { const u32x2 d = *(const u32x2*)(gp + nt * 64);
#pragma unroll
                        for (int e = 0; e < 4; ++e) r[e] = (float)((d.x >> (8 * e)) & 0xffu) * __builtin_amdgcn_rcpf((float)((d.y >> (8 * e)) & 0xffu)); }
                    else { const unsigned d = *(const unsigned*)(gp + nt * 64);
#pragma unroll
                        for (int e = 0; e < 4; ++e) r[e] = (float)((d >> (8 * e)) & 0xffu) * (1.f / 256.f); }
                    acc[nt] = acc[nt] * r; } }
        }
    }
    const size_t row = (size_t)(row0 + m0 + c);
    if (MODE == 2) { const float sc = (col0 >= C_RK && col0 < C_RV) ? 0.125f : 1.f; bf16_t* oq = (bf16_t*)(p.ws + WS_PXA) + row * PXW + col0 + n0 + 4 * g4;
#pragma unroll
        for (int nt = 0; nt < 2; ++nt) { u32x2 w; w.x = pk2(acc[nt][0] * sc, acc[nt][1] * sc); w.y = pk2(acc[nt][2] * sc, acc[nt][3] * sc); *(u32x2*)(oq + nt * 16) = w; }
        return; }
    bf16_t* op = (bf16_t*)(p.ws + (MODE == 0 ? WS_HX : WS_PXA)) + row * D + col0 + n0 + 4 * g4;
    float ss = 0.f;
#pragma unroll
    for (int nt = 0; nt < 2; ++nt) { u32x2 w; w.x = pk2(acc[nt][0], acc[nt][1]); w.y = pk2(acc[nt][2], acc[nt][3]); st_wt8(op + nt * 16, w);
        ss += (acc[nt][0] * acc[nt][0] + acc[nt][1] * acc[nt][1]) + (acc[nt][2] * acc[nt][2] + acc[nt][3] * acc[nt][3]); }
    if (MODE == 1) { ss += __shfl_xor(ss, 16); ss += __shfl_xor(ss, 32);
        if (g4 == 0) ((float*)(p.ws + WS_SSP2))[row * 32 + (col0 >> 6) * 2 + (n0 >> 5)] = ss; }
}

__device__ __forceinline__ int q_take(const F& f, unsigned* ctr) {
    __syncthreads();
    if (f.tid == 0) *(volatile LAS unsigned*)(f.lds + LDS_Q) = __hip_atomic_fetch_add(ctr, 1u, __ATOMIC_RELAXED, __HIP_MEMORY_SCOPE_AGENT);
    __syncthreads();
    return (int)*(volatile LAS unsigned*)(f.lds + LDS_Q);
}
__device__ __forceinline__ void ph_mix(const P& p, const F& f0, int l, int rep) {
    F f = f0;
    const bool upd = l < DEPTH - 1;
    unsigned* ctr = (unsigned*)(p.ws + WS_CTL) + CW_Q + (l * 2 + 0) * 64 + rep * 32;
    fft1_setup(p, f);
    for (int e = f.tid; e < 17408 / 16; e += NTHR) *(LAS u32x4*)(f.lds + LDS_FA2 + e * 16) = *(const u32x4*)(p.ws + WS_FA2 + e * 16);
    __syncthreads();
    const int nq = (upd ? 256 + 16 + 544 + 256 + 64 + 272 + 64 : 256 + 544 + 256 + 272 + 64) + 256 + 544;
    for (int t = q_take(f, ctr); t < nq; t = q_take(f, ctr)) {
        asm volatile("" : "+v"(f.tid)); f.lane = f.tid & 63;
        int r = t;
        if (r < 256) { attn_unit(p, f, l, false, r >> 6, (r >> 5) & 1, r & 31); continue; } r -= 256;
        if (l < DEPTH - 1) { if (r < 16) { attn_unit(p, f, l, true, r >> 2, (r >> 1) & 1, r & 1); continue; } r -= 16; }
        if (r < 544) { ret1_unit(p, f, l, r); continue; } r -= 544;
        if (r < 256) { fft1_unit(p, f, l, r); continue; } r -= 256;
        if (l < DEPTH - 1) { if (r < 64) { fctx_unit(p, f, r); continue; } r -= 64; }
        if (r < 272) { conv_unit(p, f, l, r); continue; } r -= 272;
        if (r < 64) { scan_unit(p, f, l, r); continue; } r -= 64;
        if (r < 256) { fft2_unit(p, f, l, r); continue; } r -= 256;
        if (upd || (r % 34) >= 2) ret2_unit(p, f, l, r);
    }
}

__global__ void __launch_bounds__(NTHR) mega(P p) {
    extern __shared__ __attribute__((aligned(16))) unsigned char lds_raw[];
#define MKF F f; f.lds = (LAS unsigned char*)lds_raw; { int t_ = threadIdx.x; asm volatile("" : "+v"(t_)); f.tid = t_; } f.lane = f.tid & 63; f.wave = __builtin_amdgcn_readfirstlane(f.tid >> 6); \
    f.bid = blockIdx.x; f.nb = gridDim.x; f.gw = f.bid * NWAVES + f.wave; f.ngw = f.nb * NWAVES;
    volatile LAS unsigned* bst = (volatile LAS unsigned*)((LAS unsigned char*)lds_raw + LDS_BYTES - 16);
    if (threadIdx.x < 4) bst[threadIdx.x] = 0u;
    __syncthreads();
    XcdBarrier bar = xcd_barrier_post((unsigned*)(p.ws + WS_CTL), bst);
    int ph = 0;
#define PHASE(T, ...) do { if (ph >= p.ph_lo && ph < p.ph_hi) { { const int rep_ = 0; (void)rep_; MKF; __VA_ARGS__; } if (REP_PHASE == (T)) { const int rep_ = 1; (void)rep_; MKF; __VA_ARGS__; } if (p.coop && ph + 1 < p.ph_hi) { if (p.coop == 2) cg::this_grid().sync(); else xcd_barrier(bar); if (REP_SYNC) { xcd_barrier(bar); xcd_barrier(bar); } } } ++ph; } while (0)
#define SUB(T, ...) do { __VA_ARGS__; if (REP_SUB == (T)) { __VA_ARGS__; } } while (0)
    PHASE(0, ph_mod(p, f));
    PHASE(1, ph_prologue(p, f));
    for (int l = 0; l < DEPTH; ++l) {
        PHASE(2, { pg8::Gemm g{(const bf16_t*)(p.ws + WS_HX), (const bf16_t*)(p.ws + WS_WIN + l * WIN_L), D};
                EpiIn E{(bf16_t*)(p.ws + WS_PXA), (bf16_t*)(p.ws + WS_GATES), (const float*)(p.ws + WS_ROPE), (const float*)(p.ws + WS_ROPE) + 1024, (PROBE_NOST && rep_ == 1) ? 1 : 0};
                if (l < DEPTH - 1) { pg8::OrderFull<68, 32> S_; S_.so.init(f.nb, f.bid); S_.nt = 16; pg8::gemm_phase<EpiIn, pg8::OrderFull<68, 32>, true, true>(f.lds, g, S_, E);
                    const int nbusy = 68 * 32 - 8 * (int)f.nb;
                    if ((int)f.bid >= nbusy && nbusy >= 0) {
                        __syncthreads();
                        for (int it = NC_FF + ((int)f.bid - nbusy) * NWAVES + f.wave; it < N_CONV_ITEMS; it += ((int)f.nb - nbusy) * NWAVES) conv_item(p, l + 1, it, (LAS float*)(f.lds + f.wave * 8448), (const LAS float*)f.lds, f.lane, 1);
                        __syncthreads(); } }
                else {
                    pg8::OrderFull<64, 32> S_; S_.so.init(f.nb, f.bid); S_.nt = 16; pg8::gemm_phase<EpiIn, pg8::OrderFull<64, 32>, true, true>(f.lds, g, S_, E);
                    for (int u = f.bid; u < 192; u += f.nb) { const int ctile = u % 12, rt = u / 12, col0 = (ctile < 4 ? 512 : 2560 - 256) + ctile * 64; gemm64_unit<2>(p, f, g.A, g.Bt, D, D, LATROWS + rt * 64, col0); } } });
        PHASE(3, ph_mix(p, f, l, rep_));
        PHASE(5, { pg8::Gemm g{(const bf16_t*)(p.ws + WS_Y), (const bf16_t*)(p.ws + WS_WO + l * WO_L), YW}; pg8::OrderBranch<64, 4> S_; S_.so.init(f.nb, f.bid);
                EpiWo E{(const unsigned char*)(p.ws + WS_GATES), (bf16_t*)(p.ws + WS_HX)};
                pg8::gemm_phase<EpiWo, pg8::OrderBranch<64, 4>, true, true>(f.lds, g, S_, E);
                if (l < DEPTH - 1) for (int u = f.bid; u < 256; u += f.nb) gemm64_unit<0>(p, f, g.A, g.Bt, YW, YW, LATROWS + (u >> 4) * 64, (u & 15) * 64); });
        PHASE(6, { pg8::Gemm g{(const bf16_t*)(p.ws + WS_HX), (const bf16_t*)(p.ws + WS_WOUT + l * WOUT_L), D}; pg8::OrderFull<64, 4> S_; S_.so.init(f.nb, f.bid); S_.nt = 16;
                EpiOut E{(bf16_t*)(p.ws + WS_PXA), (float*)(p.ws + WS_SSP2)};
                pg8::gemm_phase<EpiOut, pg8::OrderFull<64, 4>, true, true>(f.lds, g, S_, E);
                if (l < DEPTH - 1) for (int u = f.bid; u < 256; u += f.nb) gemm64_unit<1>(p, f, g.A, g.Bt, D, D, LATROWS + (u >> 4) * 64, (u & 15) * 64); });
        PHASE(7, { if (REP_PHASE == 7 && rep_ == 0) ph_post(p, f, l, 1); else if (REP_PHASE != 7 || rep_ == 1) ph_post(p, f, l, 0); });
    }
#undef PHASE
#undef SUB
}
constexpr int N_PHASES = 2 + 5 * DEPTH;

extern "C" void kernel_launch(void* const* d_in, const int* in_sizes, int n_in, void* d_out, int out_size, void* d_ws, size_t ws_size, hipStream_t stream) {
    static int grid = 0;
    if (grid == 0) {
        if (ws_size < WS_END) { fprintf(stderr, "kernel_launch: workspace too small: %zu < %zu\n", ws_size, (size_t)WS_END); grid = -1; return; }
        int dev = 0, cus = 0;
        hipGetDevice(&dev); hipDeviceGetAttribute(&cus, hipDeviceAttributeMultiprocessorCount, dev);
        hipFuncSetAttribute((const void*)mega, hipFuncAttributeMaxDynamicSharedMemorySize, LDS_BYTES);
        int per_cu = 0; hipOccupancyMaxActiveBlocksPerMultiprocessor(&per_cu, (const void*)mega, NTHR, LDS_BYTES);
        if (per_cu < 1) { fprintf(stderr, "kernel_launch: occupancy query says %d blocks/CU\n", per_cu); }
        (void)hipGetLastError();
        grid = cus;
    }
    if (grid < 0) return;
    hipMemsetAsync((char*)d_ws + WS_CTL, 0, CTL_BYTES, stream);
    P p{};
    p.x = (const float*)d_in[0]; p.c = (const float*)d_in[1]; p.ctx = (const float*)d_in[2]; p.cctx = (const float*)d_in[3]; p.w_ada = (const float*)d_in[4]; p.b_ada = (const float*)d_in[5];
    p.norm_pre = (const float*)d_in[6]; p.norm_post = (const float*)d_in[7]; p.w_in = (const float*)d_in[8]; p.sink = (const float*)d_in[9]; p.conv_w = (const float*)d_in[10]; p.conv_b = (const float*)d_in[11];
    p.ret_decay = (const float*)d_in[12]; p.w_o[0] = (const float*)d_in[13]; p.w_o[1] = (const float*)d_in[14]; p.w_o[2] = (const float*)d_in[15]; p.w_o[3] = (const float*)d_in[16]; p.w_out = (const float*)d_in[17];
    p.out = (float*)d_out; p.ws = (unsigned char*)d_ws;
#if MK_COOP
    p.ph_lo = 0; p.ph_hi = N_PHASES; p.coop = 1;
    void* args[] = {&p};
    hipError_t e = hipLaunchCooperativeKernel((const void*)mega, dim3(grid), dim3(NTHR), args, LDS_BYTES, stream);
    if (e != hipSuccess) fprintf(stderr, "cooperative launch failed: %s\n", hipGetErrorString(e));
#else
    for (int ph = 0; ph < N_PHASES; ++ph) { p.ph_lo = ph; p.ph_hi = ph + 1; p.coop = 0; hipLaunchKernelGGL(mega, dim3(grid), dim3(NTHR), LDS_BYTES, stream, p); }
#endif
}
```

```cpp
#ifndef MK_COOP
#define MK_COOP 1
#endif
#include <hip/hip_runtime.h>
#include <hip/hip_cooperative_groups.h>
#include <cstdint>
#include <cstdio>
namespace cg = cooperative_groups;

#define LAS __attribute__((address_space(3)))
typedef unsigned short bf16_t;
typedef short bf16x8 __attribute__((ext_vector_type(8)));
typedef float f32x4 __attribute__((ext_vector_type(4)));
typedef unsigned u32x4 __attribute__((ext_vector_type(4)));
typedef unsigned u32x2 __attribute__((ext_vector_type(2)));

constexpr int D = 1024, NB = 4, S = 4096, L = 256, DEPTH = 4, INW = 7936;
constexpr int LATROWS = NB * S, MROWS = NB * S + NB * L;
constexpr size_t GPLANE = (size_t)(16384 + 1024) * 1024;
constexpr int PXW = 4096, GW = 1024  , YW = 1280;
constexpr int C_AQ = 0, C_AK = 512, C_AV = 640, C_AZ = 768, C_BU = 1280, C_BB = 1536, C_BC = 1792, C_BZ = 2048,
              C_RQ = 2304, C_RK = 2560, C_RV = 2816, C_RZ = 3072, C_FC = 3328, C_FS = 3584, C_FZ = 3840;
constexpr int NWAVES = 8, NTHR = 512;
constexpr float EPS = 1e-6f;
constexpr float LOG2E = 1.4426950408889634f;
constexpr float QSCALE = 0.125f * LOG2E;
constexpr int LDS_BYTES = 163840;
#ifndef REP_PHASE
#define REP_PHASE -1
#endif
#ifndef REP_SYNC
#define REP_SYNC 0
#endif
#ifndef PROBE_ATT2
#define PROBE_ATT2 0
#endif
#ifndef PROBE_EPI
#define PROBE_EPI 0
#endif
#ifndef PROBE_EPI2
#define PROBE_EPI2 0
#endif
#ifndef PROBE_ST2
#define PROBE_ST2 0
#endif
#ifndef STAGGER_US
#define STAGGER_US 0
#endif
#ifndef PROBE_GATE2
#define PROBE_GATE2 0
#endif
#ifndef PROBE_NOST
#define PROBE_NOST 0
#endif
#ifndef REP_SUB
#define REP_SUB -1
#endif

constexpr size_t MiB = 1u << 20;
constexpr size_t WS_CTL = 0, WS_MOD = 1 * MiB, WS_ROPE = 1 * MiB + 512 * 1024, WS_SSP = 2 * MiB, WS_WIN = 4 * MiB, WS_WO = 68 * MiB, WS_WOUT = 78 * MiB,
                 WS_XC = 86 * MiB, WS_HX = 90 * MiB, WS_PXA = 124 * MiB, WS_GATES = 260 * MiB, WS_Y = 396 * MiB, WS_INCR = 439 * MiB, WS_GP = 456 * MiB, WS_STATE = 472 * MiB, WS_SSP2 = 481 * MiB, WS_END = 484 * MiB;
constexpr int CTL_BYTES = 131072, CW_Q = 4096  , CW_RC = 4096 + 1024  , CW_F1 = CW_RC + 1024  , CW_SC = CW_F1 + 256  ;
constexpr int LDS_Q = LDS_BYTES - 32;
constexpr size_t WS_XB = 328 * MiB;
constexpr size_t WS_SX = 88 * MiB;     constexpr size_t WS_OUTC = 86 * MiB  , WS_HXB = 362 * MiB  ;
constexpr int CW_TP = 17408  , CW_TC = 21504  , CW_HP = 22528  ;
constexpr int CW_PX = 8192  , CW_CP = 16384  ;
constexpr size_t WS_FA1 = WS_ROPE + 16384, WS_FA2 = WS_FA1 + 34816;
constexpr size_t WIN_L = (size_t)8192 * 1024 * 2, WO_L = (size_t)1024 * 1280 * 2, WOUT_L = (size_t)1024 * 1024 * 2;

struct P {
    const float *x, *c, *ctx, *cctx, *w_ada, *b_ada, *norm_pre, *norm_post, *w_in, *sink, *conv_w, *conv_b, *ret_decay, *w_o[4], *w_out;
    float* out; unsigned char* ws; int ph_lo, ph_hi, coop, pad;
};

__device__ __forceinline__ float bf2f(unsigned v) { return __builtin_bit_cast(float, v << 16); }
__device__ __forceinline__ unsigned f2bf(float f) { unsigned u = __builtin_bit_cast(unsigned, f); return (u + 0x7fffu + ((u >> 16) & 1u)) >> 16; }
typedef __bf16 bf2_t __attribute__((ext_vector_type(2)));
__device__ __forceinline__ unsigned pk2(float lo, float hi) { bf2_t v; v[0] = (__bf16)lo; v[1] = (__bf16)hi; return __builtin_bit_cast(unsigned, v); }
__device__ __forceinline__ float siluf(float v) { return v * __builtin_amdgcn_rcpf(1.f + __expf(-v)); }
__device__ __forceinline__ float sigmf(float v) { return 1.f / (1.f + __expf(-v)); }
__device__ __forceinline__ float wave_sum(float v) {
#pragma unroll
    for (int o = 1; o < 64; o <<= 1) v += __shfl_xor(v, o);
    return v;
}
__device__ __forceinline__ float wave_max(float v) {
#pragma unroll
    for (int o = 1; o < 64; o <<= 1) v = fmaxf(v, __shfl_xor(v, o));
    return v;
}
#define LDS_WAIT() asm volatile("s_waitcnt lgkmcnt(0)" ::: "memory")

namespace pg8 {
#define PG8_LAS __attribute__((address_space(3)))
constexpr int BM = 256, BK = 64, HALF = 128, HTB = HALF * BK * 2, STAGE_BYTES = 8 * HTB, NXCD = 8, WGM = 4;
__host__ __device__ __forceinline__ int lds_byte(int r, int c) { const int st = (r >> 4) * 2 + (c >> 5), rr = r & 15, cc = c & 31, ob = rr * 64 + cc * 2; return st * 1024 + (ob ^ (((ob >> 9) & 1) << 5)); }
__host__ __device__ __forceinline__ void stage_rc(int b, int& R, int& C) { const int st = b / 1024, sb = b % 1024, swz = sb ^ (((sb >> 9) & 1) << 5); R = (st >> 1) * 16 + swz / 64; C = (st & 1) * 32 + (swz % 64) / 2; }
__host__ __device__ __forceinline__ int perm32(int rho) { const int n = rho >> 4, i = rho & 15; return 8 * (i >> 2) + 4 * n + (i & 3); }

struct Unit { int pm, pn, kofs, nt, br; };
struct Gemm { const bf16_t* A; const bf16_t* Bt; int ld; };

template <int NM, int NN, int WGM = 4> struct StaticOrderT {
    int G, c;
    __device__ void init(int G_, int c_) { G = G_; c = c_; }
    __device__ bool tile(int i, int& pm, int& pn) const {
        constexpr int nwg = NM * NN, q = nwg / NXCD, r = nwg % NXCD, nig = WGM * NN;
        const int Lx = i * G + c; if (Lx >= nwg) return false;
        int wgid = Lx; { const int xcd = wgid % NXCD, off = wgid / NXCD; wgid = (xcd < r ? xcd * (q + 1) : r * (q + 1) + (xcd - r) * q) + off; }
        const int gid = wgid / nig, fm = gid * WGM, gsz = (NM - fm) < WGM ? (NM - fm) : WGM, w = wgid % nig, sh = 31 - __builtin_clz(gsz);
        pm = fm + (w & (gsz - 1)); pn = w >> sh; return true;
    }
};
__device__ __forceinline__ void wave_poll(unsigned* cnt, unsigned want) { unsigned spins = 0; while (__hip_atomic_load(cnt, __ATOMIC_RELAXED, __HIP_MEMORY_SCOPE_AGENT) < want && ++spins < (1u << 22)) __builtin_amdgcn_s_sleep(2); asm volatile("" ::: "memory"); }
__device__ __forceinline__ void wave_publish(unsigned* cnt) { asm volatile("s_waitcnt vmcnt(0)" ::: "memory"); if (__builtin_amdgcn_mbcnt_hi(~0u, __builtin_amdgcn_mbcnt_lo(~0u, 0u)) == 0) __hip_atomic_fetch_add(cnt, 1u, __ATOMIC_RELAXED, __HIP_MEMORY_SCOPE_AGENT); }
template <int NM, int NN, int WG = 4> struct OrderFull {
    StaticOrderT<NM, NN, WG> so; int nt; unsigned* gate = nullptr;
    __device__ bool next(int i, Unit& u) const { if (!so.tile(i, u.pm, u.pn)) return false; u.kofs = 0; u.nt = nt; u.br = i; return true; }
    __device__ __forceinline__ void a_ready(const Unit& u) const {
        if (!gate) return;
        if (u.br == 0) wave_poll(gate + u.pm * 16, u.pm < 64 ? 32u : 256u);
        else if (u.br == 1) { for (;;) { bool ok = true;
#pragma unroll 1
                for (int i = 1; ; ++i) { int pm, pn; if (!so.tile(i, pm, pn)) break; ok = ok && (__hip_atomic_load(gate + pm * 16, __ATOMIC_RELAXED, __HIP_MEMORY_SCOPE_AGENT) >= (pm < 64 ? 32u : 256u)); }
                if (ok) break; __builtin_amdgcn_s_sleep(2); }
            asm volatile("" ::: "memory"); } }
    __device__ __forceinline__ void done(const Unit&) const {}
};
template <int NM, int NN, int WG = 4> struct OrderBranch {
    StaticOrderT<NM, NN, WG> so;
    __device__ bool next(int i, Unit& u) const {
        if (!so.tile(i >> 2, u.pm, u.pn)) return false; const int br = i & 3; u.br = br;
        u.kofs = br == 0 ? 0 : 256 + 256 * br; u.nt = br == 0 ? 8 : 4; return true; }
    unsigned* pub = nullptr;
    __device__ __forceinline__ void a_ready(const Unit&) const {}
    __device__ __forceinline__ void done(const Unit& u) const { if (pub && u.br == 3) wave_publish(pub + u.pm * 16); }
};
template <class Epi, class Sched, bool ALIGN_EPI = false, bool SP2 = false>
__device__ __forceinline__ void gemm_phase(PG8_LAS unsigned char* lds, const Gemm g, const Sched& S, const Epi& E) {
    int tid_ = threadIdx.x; asm volatile("" : "+v"(tid_));
    const int tid = tid_, wid = __builtin_amdgcn_readfirstlane(tid >> 6), lane = tid & 63, wr = wid >> 2, wc = wid & 3, fr = lane & 15, fq = lane >> 4;
    const int K = g.ld;
    unsigned voffA[2], voffB[2];
#pragma unroll
    for (int i = 0; i < 2; ++i) { int R, C; stage_rc(tid * 16 + i * 8192, R, C); const int Rb = Epi::PERM ? ((R & ~31) + perm32(R & 31)) : R;
        voffA[i] = (unsigned)(R * K + C) * 2u; voffB[i] = (unsigned)(Rb * K + C) * 2u; }
    const size_t kstep = (size_t)(BK * 2);
    const size_t hstep = (size_t)HALF * K * 2;
    const size_t tstep = 2 * hstep;
    const unsigned ldsw = (unsigned)wid * 1024u;
    const int aoff = lds_byte(wr * 64 + fr, fq * 8), boff = lds_byte(wc * 32 + fr, fq * 8);
#define PG8_SA(b, h) (((b) * 2 + (h)) * HTB)
#define PG8_SB(b, h) ((4 + (b) * 2 + (h)) * HTB)
#define PG8_STAGE(bufoff, gbase, voff) do { _Pragma("unroll") for (int _i = 0; _i < 2; ++_i) \
        __builtin_amdgcn_global_load_lds((const unsigned*)((const char*)(gbase) + (voff)[_i]), (PG8_LAS unsigned*)(lds + (bufoff) + ldsw + _i * 8192), 16, 0, 0); } while (0)
#define PG8_LDA(dst, b, h) do { _Pragma("unroll") for (int m = 0; m < 4; ++m) _Pragma("unroll") for (int k = 0; k < 2; ++k) dst[m][k] = *(const PG8_LAS bf16x8*)(lds + PG8_SA(b, h) + aoff + m * 2048 + k * 1024); } while (0)
#define PG8_LDB(dst, b, h) do { _Pragma("unroll") for (int n = 0; n < 2; ++n) _Pragma("unroll") for (int k = 0; k < 2; ++k) dst[n][k] = *(const PG8_LAS bf16x8*)(lds + PG8_SB(b, h) + boff + n * 2048 + k * 1024); } while (0)
#define PG8_MMA(ai, bj, At, Bt) do { __builtin_amdgcn_s_setprio(1); _Pragma("unroll") for (int m = 0; m < 4; ++m) _Pragma("unroll") for (int n = 0; n < 2; ++n) _Pragma("unroll") for (int k = 0; k < 2; ++k) \
        acc[ai][bj][m][n] = __builtin_amdgcn_mfma_f32_16x16x32_bf16(Bt[n][k], At[m][k], acc[ai][bj][m][n], 0, 0, 0); __builtin_amdgcn_s_setprio(0); } while (0)
#define PG8_WAIT_V(n) asm volatile("s_waitcnt vmcnt(" #n ")" ::: "memory")
#define PG8_WAIT_L(n) asm volatile("s_waitcnt lgkmcnt(" #n ")" ::: "memory")
#define PG8_BAR __builtin_amdgcn_s_barrier()
#define PG8_SCHED __builtin_amdgcn_sched_barrier(0)
    Unit cur, nxt; int ui = 0;
    if (!S.next(0, cur)) return;
    f32x4 acc[2][2][4][2];
#pragma unroll
    for (int a = 0; a < 2; ++a)
#pragma unroll
        for (int b = 0; b < 2; ++b)
#pragma unroll
            for (int m = 0; m < 4; ++m)
#pragma unroll
                for (int n = 0; n < 2; ++n) acc[a][b][m][n] = (f32x4){0.f, 0.f, 0.f, 0.f};
    bf16x8 At[4][2], B0[2][2], B1[2][2];
    const char* cA = (const char*)g.A + (size_t)cur.pm * tstep + (size_t)cur.kofs * 2; const char* cB = (const char*)g.Bt + (size_t)cur.pn * tstep + (size_t)cur.kofs * 2;
    if constexpr (!SP2) S.a_ready(cur);
    if constexpr (SP2) {
        PG8_STAGE(PG8_SB(0, 0), cB, voffB); PG8_STAGE(PG8_SB(0, 1), cB + hstep, voffB);
        S.a_ready(cur);
        PG8_STAGE(PG8_SA(0, 0), cA, voffA); PG8_STAGE(PG8_SA(0, 1), cA + hstep, voffA);
        if (wr == 1) PG8_BAR;
        PG8_WAIT_V(2); PG8_BAR;
        PG8_STAGE(PG8_SB(1, 0), cB + kstep, voffB); PG8_STAGE(PG8_SA(1, 0), cA + kstep, voffA); PG8_STAGE(PG8_SB(1, 1), cB + hstep + kstep, voffB);
        PG8_WAIT_V(6); PG8_BAR;
    } else {
        PG8_STAGE(PG8_SB(0, 0), cB, voffB); PG8_STAGE(PG8_SA(0, 0), cA, voffA); PG8_STAGE(PG8_SB(0, 1), cB + hstep, voffB); PG8_STAGE(PG8_SA(0, 1), cA + hstep, voffA);
        if (wr == 1) PG8_BAR;
        PG8_WAIT_V(4); PG8_BAR;
        PG8_STAGE(PG8_SB(1, 0), cB + kstep, voffB); PG8_STAGE(PG8_SA(1, 0), cA + kstep, voffA); PG8_STAGE(PG8_SB(1, 1), cB + hstep + kstep, voffB);
        PG8_WAIT_V(6); PG8_BAR;
    }
    for (;;) {
        const bool has_next = S.next(ui + 1, nxt);
        const char* nA = has_next ? (const char*)g.A + (size_t)nxt.pm * tstep + (size_t)nxt.kofs * 2 : cA; const char* nB = has_next ? (const char*)g.Bt + (size_t)nxt.pn * tstep + (size_t)nxt.kofs * 2 : cB;
        const int nt = cur.nt;
        for (int t = 0; t < nt; t += 2) {
            const bool last = (t == nt - 2);
            const char* a1 = cA + (size_t)(t + 1) * kstep;
            const char* a2 = last ? nA : cA + (size_t)(t + 2) * kstep; const char* b2 = last ? nB : cB + (size_t)(t + 2) * kstep;
            const char* a3 = a2 + kstep; const char* b3 = b2 + kstep;
            if (last && has_next) S.a_ready(nxt);
            if constexpr (SP2) {
            PG8_LDB(B0, 0, 0); PG8_LDB(B1, 0, 1); PG8_SCHED; PG8_LDA(At, 0, 0); PG8_STAGE(PG8_SA(1, 1), a1 + hstep, voffA);
            PG8_WAIT_V(8); PG8_WAIT_L(0); PG8_BAR; PG8_MMA(0, 0, At, B0); PG8_MMA(0, 1, At, B1); PG8_BAR; PG8_SCHED;
            PG8_LDA(At, 0, 1); PG8_STAGE(PG8_SB(0, 0), b2, voffB); PG8_STAGE(PG8_SB(0, 1), b2 + hstep, voffB); PG8_STAGE(PG8_SA(0, 0), a2, voffA);
            PG8_WAIT_V(8); PG8_WAIT_L(0); PG8_BAR; PG8_MMA(1, 0, At, B0); PG8_MMA(1, 1, At, B1); PG8_BAR; PG8_SCHED;
            PG8_LDB(B0, 1, 0); PG8_LDB(B1, 1, 1); PG8_SCHED; PG8_LDA(At, 1, 0); PG8_STAGE(PG8_SA(0, 1), a2 + hstep, voffA);
            PG8_WAIT_V(8); PG8_WAIT_L(0); PG8_BAR; PG8_MMA(0, 0, At, B0); PG8_MMA(0, 1, At, B1); PG8_BAR; PG8_SCHED;
            PG8_LDA(At, 1, 1); PG8_STAGE(PG8_SB(1, 0), b3, voffB); PG8_STAGE(PG8_SB(1, 1), b3 + hstep, voffB); PG8_STAGE(PG8_SA(1, 0), a3, voffA);
            PG8_WAIT_V(8); PG8_WAIT_L(0); PG8_BAR; PG8_MMA(1, 0, At, B0); PG8_MMA(1, 1, At, B1); PG8_BAR; PG8_SCHED;
            } else {
            PG8_LDB(B0, 0, 0); PG8_SCHED; PG8_LDA(At, 0, 0); PG8_STAGE(PG8_SA(1, 1), a1 + hstep, voffA);
            PG8_WAIT_L(8); PG8_BAR; PG8_WAIT_L(0); PG8_MMA(0, 0, At, B0); PG8_BAR; PG8_SCHED;
            PG8_LDB(B1, 0, 1); PG8_STAGE(PG8_SB(0, 0), b2, voffB);
            PG8_BAR; PG8_WAIT_L(0); PG8_MMA(0, 1, At, B1); PG8_BAR;
            PG8_LDA(At, 0, 1); PG8_STAGE(PG8_SA(0, 0), a2, voffA);
            PG8_BAR; PG8_WAIT_L(0); PG8_MMA(1, 0, At, B0); PG8_BAR; PG8_SCHED;
            PG8_STAGE(PG8_SB(0, 1), b2 + hstep, voffB);
            PG8_WAIT_V(6); PG8_BAR; PG8_MMA(1, 1, At, B1); PG8_BAR;
            PG8_LDB(B0, 1, 0); PG8_SCHED; PG8_LDA(At, 1, 0); PG8_STAGE(PG8_SA(0, 1), a2 + hstep, voffA);
            PG8_WAIT_L(8); PG8_BAR; PG8_WAIT_L(0); PG8_MMA(0, 0, At, B0); PG8_BAR; PG8_SCHED;
            PG8_LDB(B1, 1, 1); PG8_STAGE(PG8_SB(1, 0), b3, voffB);
            PG8_BAR; PG8_WAIT_L(0); PG8_MMA(0, 1, At, B1); PG8_BAR;
            PG8_LDA(At, 1, 1); PG8_STAGE(PG8_SA(1, 0), a3, voffA);
            PG8_BAR; PG8_WAIT_L(0); PG8_MMA(1, 0, At, B0); PG8_BAR; PG8_SCHED;
            PG8_STAGE(PG8_SB(1, 1), b3 + hstep, voffB);
            PG8_WAIT_V(6); PG8_BAR; PG8_MMA(1, 1, At, B1); PG8_BAR;
            }
        }
        if constexpr (ALIGN_EPI) { if (wr == 0) PG8_BAR; }
        if constexpr (!Epi::AFTER_DRAIN) { E(acc, cur, wr, wc, fr, fq); S.done(cur); }
        if (!has_next) break;
        if (!(Epi::KEEP && cur.br < 3))
#pragma unroll
        for (int a = 0; a < 2; ++a)
#pragma unroll
            for (int b = 0; b < 2; ++b)
#pragma unroll
                for (int m = 0; m < 4; ++m)
#pragma unroll
                    for (int n = 0; n < 2; ++n) acc[a][b][m][n] = (f32x4){0.f, 0.f, 0.f, 0.f};
        cur = nxt; cA = nA; cB = nB; ++ui;
        if constexpr (ALIGN_EPI) { if (wr == 1) PG8_BAR; }
    }
    PG8_WAIT_V(0);
    if constexpr (!ALIGN_EPI) { if (wr == 0) PG8_BAR; }
    PG8_BAR;
    if constexpr (Epi::AFTER_DRAIN) { E.fused(acc, cur, wr, wc, fr, fq, lds, wid, lane); S.done(cur); }
#undef PG8_SA
#undef PG8_SB
#undef PG8_STAGE
#undef PG8_LDA
#undef PG8_LDB
#undef PG8_MMA
#undef PG8_WAIT_V
#undef PG8_WAIT_L
#undef PG8_BAR
#undef PG8_SCHED
}
}
using pg8::Unit;

__device__ __forceinline__ unsigned pkq(float a, float b) { return pk2(a, b); }
__device__ __forceinline__ void swap16u(unsigned& a, unsigned& b) { asm volatile("s_nop 1\n\tv_permlane16_swap_b32 %0, %1\n\ts_nop 1" : "+v"(a), "+v"(b)); }
__device__ __forceinline__ void swap32u(unsigned& a, unsigned& b) { asm volatile("s_nop 1\n\tv_permlane32_swap_b32 %0, %1\n\ts_nop 1" : "+v"(a), "+v"(b)); }
__device__ __forceinline__ void st_wt16(void* base, size_t bytes, unsigned off, const u32x4 v) { __builtin_amdgcn_raw_buffer_store_b128(v, __builtin_amdgcn_make_buffer_rsrc(base, 0, (int)bytes, 0x00020000), off, 0, 16); }
struct EpiIn {
    static constexpr bool PERM = true, AFTER_DRAIN = false, KEEP = false;
    bf16_t* pxa; bf16_t* gates; const float* ropec; const float* ropes; int skip_st;
    __device__ __forceinline__ void operator()(const f32x4 (&acc)[2][2][4][2], const Unit& u, int wr, int wc, int fr, int fq) const {
        const int pn = u.pn, row0 = u.pm * 256 + wr * 64 + fr, colw = wc * 32 + 8 * fq;
        if (pn >= 16) {
            const int t = pn - 16; unsigned char* base = (unsigned char*)gates + ((size_t)((u.pm * 4 + (t & 3)) * 4 + (t >> 2)) * 8 + (wr * 4 + wc)) * 8192 + (fq * 16 + fr) * 16;
#pragma unroll
            for (int ai = 0; ai < 2; ++ai)
#pragma unroll
                for (int m = 0; m < 4; ++m) { u32x4 wv;
#pragma unroll
                    for (int k = 0; k < 4; ++k) { const f32x4 x = acc[ai][k >> 1][m][k & 1]; unsigned d = 0u;
#pragma unroll
                        for (int e = 0; e < 4; ++e) { const float g256 = __builtin_amdgcn_rcpf(fmaf(__builtin_amdgcn_exp2f(fminf(x[e] * -LOG2E, 86.f)), 1.f / 256.f, 1.f / 256.f));
                            d = __builtin_amdgcn_cvt_pk_u8_f32(fmaxf(g256, 1.f), e, d); }
                        wv[k] = d; }
                    if (!skip_st) __builtin_nontemporal_store(wv, (u32x4*)(base + (ai * 4 + m) * 1024)); else asm volatile("" :: "v"(wv)); }
        } else {
            const bool islat = u.pm < 64;
            const bool ropeall = (pn <= 1) || pn == 9 || pn == 10, rope0 = ropeall || pn == 2;
            const float sc = pn <= 1 ? QSCALE : (pn == 10 ? 0.125f : 1.f);
            const int axis = wc & 1;
            bf16_t* base = pxa + pn * 256 + colw;
#pragma unroll
            for (int ai = 0; ai < 2; ++ai) {
                f32x4 c4v[4], s4v[4];
#pragma unroll
                for (int m = 0; m < 4; ++m) { c4v[m] = (f32x4){1.f, 1.f, 1.f, 1.f}; s4v[m] = (f32x4){0.f, 0.f, 0.f, 0.f};
                    if (rope0 && islat) { const int t = (row0 + ai * 128 + m * 16) & 4095, pos = axis ? (t & 63) : (t >> 6); c4v[m] = *(const f32x4*)(ropec + pos * 16 + 4 * fq); s4v[m] = *(const f32x4*)(ropes + pos * 16 + 4 * fq); } }
#pragma unroll
                for (int m = 0; m < 4; ++m) { const int row = row0 + ai * 128 + m * 16; bf16_t* rowp = base + (size_t)row * PXW;
                    const f32x4 c4 = c4v[m], s4 = s4v[m];
#pragma unroll
                    for (int bj = 0; bj < 2; ++bj) { f32x4 v0 = acc[ai][bj][m][0], v1 = acc[ai][bj][m][1];
                        if ((bj == 0 ? rope0 : ropeall) && islat) { const f32x4 t1 = v0, t2 = v1; v0 = t1 * c4 - t2 * s4; v1 = t2 * c4 + t1 * s4; }
                        v0 = v0 * sc; v1 = v1 * sc; u32x4 w; w.x = pk2(v0[0], v0[1]); w.y = pk2(v0[2], v0[3]); w.z = pk2(v1[0], v1[1]); w.w = pk2(v1[2], v1[3]);
                        if (!skip_st) *(u32x4*)(rowp + bj * 128) = w; else asm volatile("" :: "v"(w)); } } }
        }
    }
};
struct EpiWo {
    static constexpr bool PERM = true, AFTER_DRAIN = false, KEEP = true;
    const unsigned char* gates; bf16_t* tb;
    __device__ __forceinline__ void operator()(f32x4 (&acc)[2][2][4][2], const Unit& u, int wr, int wc, int fr, int fq) const {
        const int br = u.br, row0 = u.pm * 256 + wr * 64 + fr, col0 = u.pn * 256 + wc * 32 + 8 * fq;
        const unsigned char* gb = gates + ((size_t)((u.pm * 4 + u.pn) * 4 + br) * 8 + (wr * 4 + wc)) * 8192 + (fq * 16 + fr) * 16;
        u32x4 numv[8], denv[8];
#pragma unroll
        for (int i = 0; i < 8; ++i) numv[i] = *(const u32x4*)(gb + i * 1024);
#pragma unroll
        for (int i = 0; i < 8; ++i) { denv[i] = numv[i]; if (br < 3) denv[i] = *(const u32x4*)(gb + 65536 + i * 1024); }
#pragma unroll
        for (int ai = 0; ai < 2; ++ai)
#pragma unroll
            for (int m = 0; m < 4; ++m) { const size_t row = (size_t)(row0 + ai * 128 + m * 16);
                const u32x4 num = numv[ai * 4 + m], den = denv[ai * 4 + m];
#pragma unroll
                for (int bj = 0; bj < 2; ++bj) { const int col = col0 + bj * 128; f32x4 r[2];
#pragma unroll
                    for (int n = 0; n < 2; ++n)
#pragma unroll
                        for (int e = 0; e < 4; ++e) { const float gn = (float)((num[bj * 2 + n] >> (8 * e)) & 0xffu);
                            r[n][e] = br < 3 ? gn * __builtin_amdgcn_rcpf((float)((den[bj * 2 + n] >> (8 * e)) & 0xffu)) : gn * (1.f / 256.f); }
                    const f32x4 v0 = acc[ai][bj][m][0] * r[0], v1 = acc[ai][bj][m][1] * r[1];
                    acc[ai][bj][m][0] = v0; acc[ai][bj][m][1] = v1;
                    if (br == 3) { u32x4 w; w.x = pk2(v0[0], v0[1]); w.y = pk2(v0[2], v0[3]); w.z = pk2(v1[0], v1[1]); w.w = pk2(v1[2], v1[3]); st_wt16(tb, (size_t)MROWS * D * 2, (unsigned)((row * D + col) * 2), w); } } }
    }
};
struct EpiOut {
    static constexpr bool PERM = true, AFTER_DRAIN = false, KEEP = false;
    bf16_t* out; float* ssp;
    __device__ __forceinline__ void operator()(const f32x4 (&acc)[2][2][4][2], const Unit& u, int wr, int wc, int fr, int fq) const {
        const int row0 = u.pm * 256 + wr * 64 + fr, col0 = u.pn * 256 + wc * 32 + 8 * fq;
#pragma unroll
        for (int ai = 0; ai < 2; ++ai)
#pragma unroll
            for (int m = 0; m < 4; ++m) { const size_t row = (size_t)(row0 + ai * 128 + m * 16); float ss = 0.f;
#pragma unroll
                for (int bj = 0; bj < 2; ++bj) { const f32x4 v0 = acc[ai][bj][m][0], v1 = acc[ai][bj][m][1];
                    u32x4 w; w.x = pk2(v0[0], v0[1]); w.y = pk2(v0[2], v0[3]); w.z = pk2(v1[0], v1[1]); w.w = pk2(v1[2], v1[3]); st_wt16(out, (size_t)MROWS * D * 2, (unsigned)((row * D + col0 + bj * 128) * 2), w);
                    ss += (v0[0] * v0[0] + v0[1] * v0[1]) + (v0[2] * v0[2] + v0[3] * v0[3]) + (v1[0] * v1[0] + v1[1] * v1[1]) + (v1[2] * v1[2] + v1[3] * v1[3]); }
                ss += __shfl_xor(ss, 16); ss += __shfl_xor(ss, 32);
                if (fq == 0) { float* sp = ssp + row * 32 + (u.pn * 4 + wc) * 2; sp[0] = ss; sp[1] = 0.f; } }
    }
};

#define GAS __attribute__((address_space(1)))
#define XB_TMO      128
#define XB_XCNT(j)  (256  + 64 * (j))
#define XB_XSUB(j)  (1280 + 64 * (j))
#define XB_XGEN(j)  (2304 + 64 * (j))
#define XB_TOP      3328
#define XB_TOPGEN   3392
#define XCD_BAR_WORDS 3456
#define XB_SPIN_CAP (1u << 18)

__device__ __forceinline__ unsigned xb_ld(unsigned* p)              { return __hip_atomic_load(p, __ATOMIC_RELAXED, __HIP_MEMORY_SCOPE_AGENT); }
__device__ __forceinline__ unsigned xb_add(unsigned* p, unsigned v) { return __hip_atomic_fetch_add(p, v, __ATOMIC_RELAXED, __HIP_MEMORY_SCOPE_AGENT); }
__device__ __forceinline__ unsigned xb_xcc_id() { return (unsigned)__builtin_amdgcn_s_getreg((3 << 11) | 20) & 0xFu; }
#define XB_SPIN(cond, bar) do { unsigned _sp = 0; while (cond) { __builtin_amdgcn_s_sleep(1); \
    if ((++_sp & 255u) == 0u) { if (xb_ld(&(bar)[XB_TMO])) break; if (_sp > XB_SPIN_CAP) { atomicAdd(&(bar)[XB_TMO], 1u); break; } } } } while (0)

struct XcdBarrier {
    unsigned* bar; unsigned x;
    volatile LAS unsigned* st;
};

__device__ __forceinline__ XcdBarrier xcd_barrier_post(unsigned* bar, volatile LAS unsigned* st) {
    XcdBarrier b; b.bar = bar; b.x = xb_xcc_id(); b.st = st;
    if (threadIdx.x == 0) (void)xb_add(&bar[XB_XCNT(b.x)], 1u);
    return b;
}
__device__ __forceinline__ void xcd_barrier_complete(unsigned* bar, unsigned x, unsigned& nloc, unsigned& nx) {
    const unsigned G = gridDim.x * gridDim.y * gridDim.z;
    unsigned sum, cnt, mine, sp = 0u;
    for (;;) {
        sum = 0u; cnt = 0u; mine = 0u;
#pragma unroll 1
        for (unsigned j = 0; j < 16; ++j) { const unsigned c = xb_ld(&bar[XB_XCNT(j)]); sum += c; cnt += (c > 0u) ? 1u : 0u; mine = (j == x) ? c : mine; }
        if (sum == G) break;
        __builtin_amdgcn_s_sleep(1);
        if ((++sp & 255u) == 0u) { if (xb_ld(&bar[XB_TMO])) break; if (sp > XB_SPIN_CAP) { atomicAdd(&bar[XB_TMO], 1u); break; } }
    }
    nloc = mine > 0u ? mine : 1u; nx = cnt > 0u ? cnt : 1u;
}

__device__ __forceinline__ void xcd_barrier(const XcdBarrier& b) {
    asm volatile("s_waitcnt vmcnt(0)" ::: "memory");
    __syncthreads();
    if (threadIdx.x == 0) {
        unsigned* bar = b.bar;
        __builtin_amdgcn_s_waitcnt(0);
        unsigned nloc = b.st[0], nx = b.st[1];
        if (nloc == 0u) { xcd_barrier_complete(bar, b.x, nloc, nx); b.st[0] = nloc; b.st[1] = nx; }
        const unsigned old = xb_add(&bar[XB_XSUB(b.x)], 1u);
        const unsigned gen = old / nloc;
        if (old + 1u == (gen + 1u) * nloc) {
            __builtin_amdgcn_fence(__ATOMIC_RELEASE, "agent");
            asm volatile("s_waitcnt vmcnt(0)" ::: "memory");
            const unsigned og = xb_add(&bar[XB_TOP], 1u);
            const unsigned tg = og / nx;
            if (og + 1u == (tg + 1u) * nx) xb_add(&bar[XB_TOPGEN], 1u);
            else XB_SPIN(xb_ld(&bar[XB_TOPGEN]) == tg, bar);
            __builtin_amdgcn_fence(__ATOMIC_ACQUIRE, "agent");
            xb_add(&bar[XB_XGEN(b.x)], 1u);
            asm volatile("s_waitcnt vmcnt(0)" ::: "memory");
        } else {
            XB_SPIN(xb_ld(&bar[XB_XGEN(b.x)]) == gen, bar);
            __builtin_amdgcn_fence(__ATOMIC_ACQUIRE, "agent");
            asm volatile("s_waitcnt vmcnt(0)" ::: "memory");
        }
    }
    __syncthreads();
}

__device__ __forceinline__ bf16_t* hxbuf(unsigned char* ws, int l) { return (bf16_t*)(ws + ((l & 1) ? WS_HXB : WS_HX)); }
struct F {
    LAS unsigned char* lds; int tid, lane, wave, bid, nb, gw, ngw, dup;
    mutable unsigned pendn;
    mutable unsigned qpar;
    mutable unsigned* pend;
};
__device__ __forceinline__ const float* xrow_in(const P& p, int l, int row) {
    if (l == 0) return row < LATROWS ? p.x + (size_t)row * D : p.ctx + (size_t)(row - LATROWS) * D;
    return row < LATROWS ? p.out + (size_t)row * D : (const float*)(p.ws + WS_XC) + (size_t)(row - LATROWS) * D;
}
__device__ __forceinline__ float* xrow_out(const P& p, int row) { return row < LATROWS ? p.out + (size_t)row * D : (float*)(p.ws + WS_XC) + (size_t)(row - LATROWS) * D; }
__device__ __forceinline__ const float* mod_row(const P& p, int l, int row) { const int src = row < LATROWS ? (row >> 12) : 4; return (const float*)(p.ws + WS_MOD) + ((size_t)l * 5 + src) * 3 * D; }

template <bool WT = false> __device__ __forceinline__ void hx_row(const f32x4 (&v)[4], const float* g, const float* mod, bf16_t* orow, int lane) {
    float ss = 0.f;
#pragma unroll
    for (int j = 0; j < 4; ++j) ss += (v[j][0] * v[j][0] + v[j][1] * v[j][1]) + (v[j][2] * v[j][2] + v[j][3] * v[j][3]);
    const float rs = rsqrtf(wave_sum(ss) * (1.f / D) + EPS);
    f32x4 g4v[4], shv[4], scv[4];
#pragma unroll
    for (int j = 0; j < 4; ++j) { const int col = 4 * lane + 256 * j; g4v[j] = *(const f32x4*)(g + col); shv[j] = *(const f32x4*)(mod + col); scv[j] = *(const f32x4*)(mod + D + col); }
#pragma unroll
    for (int j = 0; j < 4; ++j) { const int col = 4 * lane + 256 * j; const f32x4 g4 = g4v[j], sh = shv[j], sc = scv[j];
        const f32x4 h = v[j] * rs * g4 * (sc + 1.f) + sh; u32x2 w; w.x = pk2(h[0], h[1]); w.y = pk2(h[2], h[3]);
        if (WT) __hip_atomic_store((unsigned long long*)(orow + col), (unsigned long long)w.x | ((unsigned long long)w.y << 32), __ATOMIC_RELAXED, __HIP_MEMORY_SCOPE_AGENT); else *(u32x2*)(orow + col) = w; }
}

__device__ __forceinline__ void ph_mod(const P& p, const F& f) {
    LAS float* sc = (LAS float*)f.lds;
    LAS float* red = (LAS float*)(f.lds + 20480);
    float* mod = (float*)(p.ws + WS_MOD);
    for (int i = f.tid; i < 5 * D; i += NTHR) sc[i] = siluf(i < 4 * D ? p.c[i] : p.cctx[i - 4 * D]);
    __syncthreads();
    for (int u = f.bid; u < 4 * 48; u += f.nb) {
        const int l = u / 48, col = (u % 48) * 64 + f.lane;
        const float* w = p.w_ada + (size_t)l * D * 3 * D + col;
        float acc[5] = {0.f, 0.f, 0.f, 0.f, 0.f};
#pragma unroll 1
        for (int k0 = 0; k0 < 128; k0 += 32) { float wv[32];
#pragma unroll
            for (int kk = 0; kk < 32; ++kk) wv[kk] = w[(size_t)(f.wave * 128 + k0 + kk) * 3 * D];
#pragma unroll
            for (int kk = 0; kk < 32; ++kk) { const int k = f.wave * 128 + k0 + kk;
#pragma unroll
                for (int s5 = 0; s5 < 5; ++s5) acc[s5] += sc[s5 * D + k] * wv[kk]; } }
#pragma unroll
        for (int s5 = 0; s5 < 5; ++s5) red[(f.wave * 5 + s5) * 64 + f.lane] = acc[s5];
        __syncthreads();
        if (f.wave < 5) { float t = 0.f;
#pragma unroll
            for (int w8 = 0; w8 < 8; ++w8) t += red[(w8 * 5 + f.wave) * 64 + f.lane];
            mod[((size_t)l * 5 + f.wave) * 3 * D + col] = t + p.b_ada[l * 3 * D + col]; }
        __syncthreads();
    }
}

__device__ __forceinline__ int sigma32(int q) { return 16 * ((q >> 2) & 1) + 4 * (q >> 3) + (q & 3); }
struct TrD { const float* W; bf16_t* WT; int N, ldo, orow0, koff, k0, scol0, mode; bool ok; };
__device__ __forceinline__ void tr_load(const TrD& d, int lane, f32x4 (&wv)[8]) {
    const int jq = lane & 7, j0 = 4 * jq, sc = d.scol0 + (d.mode == 0 ? j0 : sigma32(j0));
#pragma unroll
    for (int i = 0; i < 8; ++i) wv[i] = *(const f32x4*)(d.W + (size_t)(d.k0 + (lane >> 3) + 8 * i) * d.N + sc);
}
__device__ __forceinline__ void tr_finish(const TrD& d, LAS float* scr, int lane, const f32x4 (&wv)[8]) {
    const int jq = lane & 7, j0 = 4 * jq;
#pragma unroll
    for (int i = 0; i < 8; ++i) { LAS float* q = scr + ((lane >> 3) + 8 * i) * 33 + j0; q[0] = wv[i][0]; q[1] = wv[i][1]; q[2] = wv[i][2]; q[3] = wv[i][3]; }
    LDS_WAIT();
    const int c = lane & 7;
#pragma unroll
    for (int jj = 0; jj < 4; ++jj) { const int n = (lane >> 3) + 8 * jj; const LAS float* sp = scr + (8 * c) * 33 + n;
        u32x4 o; o.x = pk2(sp[0 * 33], sp[1 * 33]); o.y = pk2(sp[2 * 33], sp[3 * 33]); o.z = pk2(sp[4 * 33], sp[5 * 33]); o.w = pk2(sp[6 * 33], sp[7 * 33]);
        *(u32x4*)(d.WT + (size_t)(d.orow0 + n) * d.ldo + d.koff + d.k0 + 8 * c) = o; }
    LDS_WAIT();
}
__device__ __forceinline__ void ff_item(const float* W, bf16_t* WT, int part, int g, int chalf, int kb, LAS float* scr, const LAS float* trig, int lane) {
#pragma unroll 1
    for (int hp = 0; hp < 2; ++hp) { const int k0 = 64 * kb + 32 * hp;
        { float wv[32];
#pragma unroll
            for (int kk = 0; kk < 32; ++kk) wv[kk] = W[(size_t)(k0 + kk) * INW + 3328 + g * 64 + lane];
#pragma unroll
            for (int kk = 0; kk < 32; ++kk) scr[kk * 65 + lane] = wv[kk]; }
        LDS_WAIT();
        const int c4 = lane & 3;
        for (int jj = 0; jj < 2; ++jj) { const int n = (lane >> 2) + 16 * jj, cp = chalf * 32 + n;
            float a[8] = {0.f, 0.f, 0.f, 0.f, 0.f, 0.f, 0.f, 0.f};
            for (int c = 0; c < 64; ++c) { const float tv = trig[part * 64 + ((c * cp) & 63)];
#pragma unroll
                for (int q = 0; q < 8; ++q) a[q] += scr[(8 * c4 + q) * 65 + c] * tv; }
            u32x4 o; o.x = pk2(a[0], a[1]); o.y = pk2(a[2], a[3]); o.z = pk2(a[4], a[5]); o.w = pk2(a[6], a[7]);
            *(u32x4*)(WT + (size_t)((part ? C_FS : C_FC) + g * 64 + cp) * D + k0 + 8 * c4) = o; }
        LDS_WAIT(); }
}
constexpr int NC_FF = 256, NC_WIN = 16 * 256, NC_WO = 20 * 32, NC_WOUT = 16 * 32, N_CONV_ITEMS = NC_FF + NC_WIN + NC_WO + NC_WOUT;
__device__ __forceinline__ TrD conv_desc(const float* w_in, const float* wo0, const float* wo1, const float* wo2, const float* wo3, const float* w_out, unsigned char* ws, int l, int it) {
    const float* W = nullptr; bf16_t* WT = nullptr; int N = 0, ldo = 0, orow0 = 0, koff = 0, k0 = 0, scol0 = 0, mode = 0; bool ok = false;
    const int r0 = it - NC_FF;
    if (r0 >= 0 && it < N_CONV_ITEMS) {
        if (r0 < NC_WIN) { const int nbk = r0 & 255, kb = (r0 >> 8) & 15, p0 = nbk * 32;
            if (!(p0 >= C_FC && p0 < C_FZ)) {
                if (p0 < C_FC) { scol0 = p0; mode = ((p0 < 640) || (p0 >= C_RQ && p0 < C_RV)) ? 1 : 0; }
                else if (p0 < 4096) scol0 = 3584 + (p0 - C_FZ);
                else scol0 = 3840 + (p0 - 4096);
                W = w_in + (size_t)l * D * INW; N = INW; WT = (bf16_t*)(ws + WS_WIN + l * WIN_L); ldo = D; orow0 = p0; k0 = kb * 64; ok = true; } }
        else if (r0 < NC_WIN + NC_WO) { const int r = r0 - NC_WIN, nbk = r & 31, kbb = r >> 5;
            const int br = kbb < 8 ? 0 : 1 + (kbb - 8) / 4, kb = kbb < 8 ? kbb : (kbb - 8) % 4, Kb = br == 0 ? 512 : 256;
            W = (br == 0 ? wo0 : br == 1 ? wo1 : br == 2 ? wo2 : wo3) + (size_t)l * Kb * D; N = D; WT = (bf16_t*)(ws + WS_WO + l * WO_L); ldo = YW; orow0 = nbk * 32; koff = br == 0 ? 0 : 256 + 256 * br; k0 = kb * 64; scol0 = nbk * 32; ok = true; }
        else { const int r = r0 - NC_WIN - NC_WO, nbk = r & 31, kb = r >> 5;
            W = w_out + (size_t)l * D * D; N = D; WT = (bf16_t*)(ws + WS_WOUT + l * WOUT_L); ldo = D; orow0 = nbk * 32; k0 = kb * 64; scol0 = nbk * 32; ok = true; } }
    TrD d; d.W = W; d.WT = WT; d.N = N; d.ldo = ldo; d.orow0 = orow0; d.koff = koff; d.k0 = k0; d.scol0 = scol0; d.mode = mode; d.ok = ok; return d;
}
__device__ __forceinline__ void conv_ff(const P& p, int l, int it, LAS float* scr, const LAS float* trig, int lane) {
    const int r = it, kb = r & 15, chalf = (r >> 4) & 1, g = (r >> 5) & 3, part = (r >> 7) & 1;
    ff_item(p.w_in + (size_t)l * D * INW, (bf16_t*)(p.ws + WS_WIN + l * WIN_L), part, g, chalf, kb, scr, trig, lane);
}
__device__ __forceinline__ void conv_stream(const P& p, int l, int first, int stride, int last, LAS float* scr, int lane) {
    if (first >= last) return;
    const float* w_in = p.w_in; const float* wo0 = p.w_o[0]; const float* wo1 = p.w_o[1]; const float* wo2 = p.w_o[2]; const float* wo3 = p.w_o[3]; const float* w_out = p.w_out; unsigned char* ws = p.ws;
#define CDESC(ix) conv_desc(w_in, wo0, wo1, wo2, wo3, w_out, ws, l, (ix))
    f32x4 wA[8], wB[8];
    { const TrD d = CDESC(first); if (d.ok) tr_load(d, lane, wA); }
#pragma unroll 1
    for (int it = first; it < last; it += 2 * stride) { const int i1 = it + stride, i2 = it + 2 * stride;
        if (i1 < last) { const TrD d = CDESC(i1); if (d.ok) tr_load(d, lane, wB); }
        { const TrD d = CDESC(it); if (d.ok) tr_finish(d, scr, lane, wA); }
        if (i2 < last) { const TrD d = CDESC(i2); if (d.ok) tr_load(d, lane, wA); }
        if (i1 < last) { const TrD d = CDESC(i1); if (d.ok) tr_finish(d, scr, lane, wB); }
    }
#undef CDESC
}
__device__ __forceinline__ void ph_prologue(const P& p, const F& f) {
    LAS float* scr = (LAS float*)(f.lds + f.wave * 8448);
    LAS float* trig = (LAS float*)(f.lds + 8 * 8448);
    if (f.tid < 64) { trig[f.tid] = cospif(f.tid / 32.f); trig[64 + f.tid] = sinpif(f.tid / 32.f); }
    __syncthreads();
    for (int k = f.gw; k < 4 * NC_FF; k += f.ngw) conv_ff(p, k & 3, k >> 2, scr, trig, f.lane);
    for (int it = f.gw - 4 * NC_FF; it >= 0 && it < 3; it += f.ngw) {
        if (it == 1 || it == 2) {
            const bool s1 = it == 1; bf16_t* dst = (bf16_t*)(p.ws + (s1 ? WS_FA1 : WS_FA2));
            for (int e = f.lane; e < (s1 ? 128 : 64) * 128; e += 64) { const int i = e >> 7, k = e & 127, ip = k >> 6, n1 = k & 63; float v;
                if (s1) { const int op = i >> 6, k1 = i & 63, ph = (k1 * n1) & 63; const float cv = cospif(ph / 32.f), sv = sinpif(ph / 32.f); v = op == 0 ? (ip == 0 ? cv : -sv) : (ip == 0 ? -sv : -cv); }
                else { const int ph = (i * n1) & 63; v = ip == 0 ? cospif(ph / 32.f) : sinpif(ph / 32.f); }
                dst[i * 136 + k] = (bf16_t)f2bf(v); }
            continue; }
        {
            float* rc = (float*)(p.ws + WS_ROPE); float* rsn = rc + 1024;
            for (int i = f.lane; i < 1024; i += 64) { const int pos = i >> 4, j = i & 15; const float inv = powf(10000.f, -(float)j / 16.f), ang = (float)pos * inv; rc[i] = cosf(ang); rsn[i] = sinf(ang); }
        }
    }
    conv_stream(p, 0, NC_FF + (int)((f.gw + f.ngw / 2) % f.ngw), f.ngw, N_CONV_ITEMS, scr, f.lane);
    for (int row = f.gw; row < MROWS; row += f.ngw) {
        const float* xr = xrow_in(p, 0, row); f32x4 v[4];
#pragma unroll
        for (int j = 0; j < 4; ++j) v[j] = *(const f32x4*)(xr + 4 * f.lane + 256 * j);
        hx_row(v, p.norm_pre, mod_row(p, 0, row), (bf16_t*)(p.ws + WS_HX) + (size_t)row * D, f.lane);
    }
}

__device__ __forceinline__ void post_row(const P& p, const F& f, int l, int row) {
    const bf16_t* outb = (const bf16_t*)(p.ws + WS_OUTC) - (size_t)LATROWS * D; const float* ssp = (const float*)(p.ws + WS_SSP2); bf16_t* xb = (bf16_t*)(p.ws + WS_XB);
    const bf16_t* orow = outb + (size_t)row * D; const float* mod = mod_row(p, l, row);
    const float sp = f.lane < 32 ? ssp[(size_t)row * 32 + f.lane] : 0.f;
    const float rs = rsqrtf(wave_sum(sp) * (1.f / D) + EPS);
    f32x4 v[4], ov[4], xv[4];
#pragma unroll
    for (int j = 0; j < 4; ++j) { const int col = 4 * f.lane + 256 * j; const u32x2 ow = *(const u32x2*)(orow + col); ov[j] = (f32x4){bf2f(ow.x & 0xffffu), bf2f(ow.x >> 16), bf2f(ow.y & 0xffffu), bf2f(ow.y >> 16)};
        if (l == 0) xv[j] = __builtin_nontemporal_load((const f32x4*)(xrow_in(p, 0, row) + col));
        else { const u32x2 xw = __builtin_nontemporal_load((const u32x2*)(xb + (size_t)row * D + col)); xv[j] = (f32x4){bf2f(xw.x & 0xffffu), bf2f(xw.x >> 16), bf2f(xw.y & 0xffffu), bf2f(xw.y >> 16)}; } }
#pragma unroll
    for (int j = 0; j < 4; ++j) { const int col = 4 * f.lane + 256 * j; const f32x4 gt = *(const f32x4*)(mod + 2 * D + col), gp = *(const f32x4*)(p.norm_post + l * D + col); v[j] = xv[j] + gt * (ov[j] * rs * gp); }
#pragma unroll
    for (int j = 0; j < 4; ++j) { const int col = 4 * f.lane + 256 * j; u32x2 w; w.x = pk2(v[j][0], v[j][1]); w.y = pk2(v[j][2], v[j][3]); __builtin_nontemporal_store(w, (u32x2*)(xb + (size_t)row * D + col)); }
    hx_row<true>(v, p.norm_pre + (l + 1) * D, mod_row(p, l + 1, row), hxbuf(p.ws, l + 1) + (size_t)row * D, f.lane);
    pg8::wave_publish((unsigned*)(p.ws + WS_CTL) + CW_HP + ((l + 1) * 80 + 64 + ((row - LATROWS) >> 8)) * 16);
}

__device__ __forceinline__ void unpack8(const u32x4 w, float (&o)[8]) { o[0] = bf2f(w.x & 0xffffu); o[1] = bf2f(w.x >> 16); o[2] = bf2f(w.y & 0xffffu); o[3] = bf2f(w.y >> 16); o[4] = bf2f(w.z & 0xffffu); o[5] = bf2f(w.z >> 16); o[6] = bf2f(w.w & 0xffffu); o[7] = bf2f(w.w >> 16); }
__device__ __forceinline__ void conv_unit(const P& p, const F& f, int l, int u) {
    const bf16_t* pxa = (const bf16_t*)(p.ws + WS_PXA); bf16_t* Y = (bf16_t*)(p.ws + WS_Y);
    const float* cw = p.conv_w + l * 768; const float* cb = p.conv_b + l * 256;
    const int row0 = u * 64 + (f.tid >> 5) * 4, c0 = (f.tid & 31) * 8;
    const bool lat = row0 < LATROWS; const int t0 = lat ? (row0 & 4095) : ((row0 - LATROWS) & 255), n = lat ? S : L;
    const bool hm = t0 > 0, hp = t0 + 3 < n - 1; const float mm = hm ? 1.f : 0.f, mp = hp ? 1.f : 0.f;
    const bf16_t* base = pxa + (size_t)row0 * PXW + c0;
    u32x4 ru[6], rc[6], rb[4], rz[4];
#pragma unroll
    for (int j = 0; j < 6; ++j) { const int dj = j == 0 ? (hm ? -1 : 0) : (j == 5 ? (hp ? 4 : 3) : j - 1); const bf16_t* rp = base + (ptrdiff_t)dj * PXW; ru[j] = *(const u32x4*)(rp + C_BU); rc[j] = *(const u32x4*)(rp + C_BC); }
#pragma unroll
    for (int k = 0; k < 4; ++k) { const bf16_t* rp = base + (size_t)k * PXW; rb[k] = *(const u32x4*)(rp + C_BB); rz[k] = *(const u32x4*)(rp + C_BZ); }
    float cwv[3][8], cbv[8];
#pragma unroll
    for (int h4 = 0; h4 < 2; ++h4) { const f32x4 b4 = *(const f32x4*)(cb + c0 + 4 * h4);
#pragma unroll
        for (int e = 0; e < 4; ++e) cbv[4 * h4 + e] = b4[e];
#pragma unroll
        for (int tp = 0; tp < 3; ++tp) { const f32x4 w4 = *(const f32x4*)(cw + tp * 256 + c0 + 4 * h4);
#pragma unroll
            for (int e = 0; e < 4; ++e) cwv[tp][4 * h4 + e] = w4[e]; } }
    __builtin_amdgcn_sched_barrier(0);
    float pr[6][8];
#pragma unroll
    for (int j = 0; j < 6; ++j) { float uu[8], cc[8]; unpack8(ru[j], uu); unpack8(rc[j], cc); const float mk = j == 0 ? mm : (j == 5 ? mp : 1.f);
#pragma unroll
        for (int i = 0; i < 8; ++i) pr[j][i] = mk * uu[i] * cc[i]; }
#pragma unroll
    for (int k = 0; k < 4; ++k) { float bb[8], bz[8], o[8]; unpack8(rb[k], bb); unpack8(rz[k], bz);
#pragma unroll
        for (int i = 0; i < 8; ++i) o[i] = bb[i] * (pr[k][i] * cwv[0][i] + pr[k + 1][i] * cwv[1][i] + pr[k + 2][i] * cwv[2][i] + cbv[i]) * siluf(bz[i]);
        u32x4 w; w.x = pk2(o[0], o[1]); w.y = pk2(o[2], o[3]); w.z = pk2(o[4], o[5]); w.w = pk2(o[6], o[7]);
        *(u32x4*)(Y + (size_t)(row0 + k) * YW + 512 + c0) = w; }
}

typedef short s16x4 __attribute__((ext_vector_type(4)));
__device__ __forceinline__ bf16x8 cat4(s16x4 a, s16x4 b) { return __builtin_shufflevector(a, b, 0, 1, 2, 3, 4, 5, 6, 7); }
#define MFMA16(a, b, c) __builtin_amdgcn_mfma_f32_16x16x32_bf16(a, b, c, 0, 0, 0)
__device__ __forceinline__ s16x4 ld_tr(const LAS unsigned char* q) { return __builtin_amdgcn_ds_read_tr16_b64_v4i16((LAS s16x4*)q); }
__device__ __forceinline__ bf16x8 frag_tr8(const LAS unsigned char* X, int pitch, int k0, int col0, int c, int g) {
    const LAS unsigned char* q = X + ((k0 + 8 * g + (c >> 2)) * pitch + col0 + 4 * (c & 3)) * 2; return cat4(ld_tr(q), ld_tr(q + 8 * pitch)); }
__device__ __forceinline__ bf16x8 frag_tr_pv(const LAS unsigned char* X, int pitch, int k0, int col0, int c, int g) {
    const LAS unsigned char* q = X + ((k0 + 4 * g + (c >> 2)) * pitch + col0 + 4 * (c & 3)) * 2; return cat4(ld_tr(q), ld_tr(q + 32 * pitch)); }
constexpr int KS_PITCH = 72, VS_PITCH = 80;
__device__ __forceinline__ float ex2(float x) { return __builtin_amdgcn_exp2f(x); }
constexpr float ATT_LAZY = 8.f;
#define FBITS(x) __builtin_bit_cast(int, (float)(x))
__device__ __forceinline__ void swap16(float& a, float& b) { asm volatile("s_nop 1\n\tv_permlane16_swap_b32 %0, %1\n\ts_nop 1" : "+v"(a), "+v"(b)); }
__device__ __forceinline__ void swap32(float& a, float& b) { asm volatile("s_nop 1\n\tv_permlane32_swap_b32 %0, %1\n\ts_nop 1" : "+v"(a), "+v"(b)); }
__device__ __forceinline__ float rows_max(float x) { float a = x, b = x; swap16(a, b); float m = fmaxf(a, b), c = m; swap32(m, c); return fmaxf(m, c); }
__device__ __forceinline__ float rows_sum(float x) { float a = x, b = x; swap16(a, b); float m = a + b, c = m; swap32(m, c); return m + c; }

constexpr int ATT_BUF = 38912;
__device__ __forceinline__ int attn_next_tile(int ti, bool ctxq, int blk, int b, int& krow0, int& mtype) {
    for (; ti < 5; ++ti) {
        if (ti < 3) { if (ctxq) continue; const int kb = blk - 1 + ti; if (kb < 0 || kb > 31) continue; krow0 = b * S + kb * 128; mtype = ti == 0 ? 1 : (ti == 2 ? 2 : 0); return ti; }
        krow0 = LATROWS + b * L + (ti - 3) * 128; mtype = 0; return ti; }
    return 5;
}
__device__ __forceinline__ void attn_tile(const int MT, const LAS unsigned char* Ks, const LAS unsigned char* Vs, const bf16x8 (&qf)[4][2], f32x4 (&o)[4][4], float (&mrun)[4], f32x4 (&osum)[4], int th, int c, int g) {
    const u32x4 onesw = {0x3F803F80u, 0x3F803F80u, 0x3F803F80u, 0x3F803F80u}; const bf16x8 ones = __builtin_bit_cast(bf16x8, onesw);
    const int sub0 = (MT == 1 && th == 1) ? 2 : 0, sub1 = (MT == 2 && th == 0) ? 2 : 4;
    bf16x8 kf[2][2];
#define ATT_KLOAD(sb) do { _Pragma("unroll") for (int kt = 0; kt < 2; ++kt) { const LAS unsigned char* kp = Ks + (((sb) * 32 + kt * 16 + c) * KS_PITCH + 8 * g) * 2; kf[kt][0] = *(const LAS bf16x8*)kp; kf[kt][1] = *(const LAS bf16x8*)(kp + 64); } } while (0)
    ATT_KLOAD(sub0);
#pragma unroll 1
    for (int sub = sub0; sub < sub1; ++sub) {
        f32x4 s[2][4];
#pragma unroll
        for (int kt = 0; kt < 2; ++kt)
#pragma unroll
            for (int qt = 0; qt < 4; ++qt) { const float nm = -mrun[qt]; f32x4 a = MFMA16(kf[kt][0], qf[qt][0], ((f32x4){nm, nm, nm, nm})); s[kt][qt] = MFMA16(kf[kt][1], qf[qt][1], a); }
        { const int sn = sub + 1 < sub1 ? sub + 1 : sub; ATT_KLOAD(sn); }
        bf16x8 vf[4];
#pragma unroll
        for (int et = 0; et < 4; ++et) vf[et] = frag_tr_pv(Vs, VS_PITCH, sub * 32, et * 16, c, g);
        __builtin_amdgcn_sched_barrier(0);
        if (MT != 0) {
            asm volatile("; masked tile" ::: "memory");
            const int sg = MT == 1 ? 1 : -1, dq = sg * (th * 64 + c - 4 * g - sub * 32);
#pragma unroll
            for (int kt = 0; kt < 2; ++kt)
#pragma unroll
                for (int qt = 0; qt < 4; ++qt)
#pragma unroll
                    for (int r = 0; r < 4; ++r) { const int e = sg * (kt * 16 + r - qt * 16); if (e < dq) s[kt][qt][r] = -INFINITY; }
        }
        int mi[4];
#pragma unroll
        for (int qt = 0; qt < 4; ++qt) { int m_ = max(max(FBITS(s[0][qt][0]), FBITS(s[0][qt][1])), FBITS(s[0][qt][2])); m_ = max(max(m_, FBITS(s[0][qt][3])), FBITS(s[1][qt][0])); m_ = max(max(m_, FBITS(s[1][qt][1])), FBITS(s[1][qt][2])); mi[qt] = max(m_, FBITS(s[1][qt][3])); }
        if (__any(max(max(mi[0], mi[1]), max(mi[2], mi[3])) > FBITS(ATT_LAZY))) {
#pragma unroll
            for (int qt = 0; qt < 4; ++qt) if (__any(mi[qt] > FBITS(ATT_LAZY))) {
                float mx = fmaxf(fmaxf(fmaxf(s[0][qt][0], s[0][qt][1]), fmaxf(s[0][qt][2], s[0][qt][3])), fmaxf(fmaxf(s[1][qt][0], s[1][qt][1]), fmaxf(s[1][qt][2], s[1][qt][3])));
                mx = rows_max(mx); const float d = fmaxf(mx, 0.f), alpha = ex2(-d); mrun[qt] += d; osum[qt] = osum[qt] * alpha;
#pragma unroll
                for (int r = 0; r < 4; ++r) { s[0][qt][r] -= d; s[1][qt][r] -= d; }
#pragma unroll
                for (int et = 0; et < 4; ++et) o[et][qt] = o[et][qt] * alpha; } }
        bf16x8 pf[4];
#pragma unroll
        for (int qt = 0; qt < 4; ++qt) { f32x4 a, bq;
#pragma unroll
            for (int r = 0; r < 4; ++r) { a[r] = ex2(s[0][qt][r]); bq[r] = ex2(s[1][qt][r]); }
            u32x4 w; w.x = pk2(a[0], a[1]); w.y = pk2(a[2], a[3]); w.z = pk2(bq[0], bq[1]); w.w = pk2(bq[2], bq[3]); pf[qt] = __builtin_bit_cast(bf16x8, w);
            osum[qt] = MFMA16(ones, pf[qt], osum[qt]); }
#pragma unroll
        for (int et = 0; et < 4; ++et)
#pragma unroll
            for (int qt = 0; qt < 4; ++qt) o[et][qt] = MFMA16(vf[et], pf[qt], o[et][qt]);
    }
#undef ATT_KLOAD
}
__device__ __forceinline__ void attn_unit(const P& p, const F& f, int l, bool ctxq, int b, int kvh, int blk) {
    const bf16_t* pxa = (const bf16_t*)(p.ws + WS_PXA); bf16_t* Y = (bf16_t*)(p.ws + WS_Y);
    const int c = f.lane & 15, g = f.lane >> 4, hg = f.wave & 3, th = f.wave >> 2, h = kvh * 4 + hg;
    const int qrow0 = (ctxq ? LATROWS + b * L + blk * 128 : b * S + blk * 128) + th * 64;
    bf16x8 qf[4][2];
#pragma unroll
    for (int qt = 0; qt < 4; ++qt)
#pragma unroll
        for (int ks = 0; ks < 2; ++ks) qf[qt][ks] = *(const bf16x8*)(pxa + (size_t)(qrow0 + qt * 16 + c) * PXW + C_AQ + h * 64 + ks * 32 + 8 * g);
    f32x4 o[4][4];
#pragma unroll
    for (int et = 0; et < 4; ++et)
#pragma unroll
        for (int qt = 0; qt < 4; ++qt) o[et][qt] = (f32x4){0.f, 0.f, 0.f, 0.f};
    float mrun[4]; f32x4 osum[4];
    const float sk = p.sink[l * 8 + h] * LOG2E, l0s = PROBE_ATT2 ? 2.f : 1.f;
#pragma unroll
    for (int qt = 0; qt < 4; ++qt) { mrun[qt] = sk; osum[qt] = (f32x4){l0s, l0s, l0s, l0s}; }
    const int skey = f.tid >> 3, sch = f.tid & 7;
    int krow0 = 0, mtype = 0; int ti = attn_next_tile(0, ctxq, blk, b, krow0, mtype);
    u32x4 kreg[2], vreg[2];
#pragma unroll
    for (int i = 0; i < 2; ++i) { const bf16_t* rp = pxa + (size_t)(krow0 + skey + 64 * i) * PXW + kvh * 64 + sch * 8; kreg[i] = *(const u32x4*)(rp + C_AK); vreg[i] = *(const u32x4*)(rp + C_AV); }
    int cur = 0;
    __syncthreads();
    while (ti < 5) {
        LAS unsigned char* Ks = f.lds + cur * ATT_BUF; LAS unsigned char* Vs = Ks + 18432;
#pragma unroll
        for (int i = 0; i < 2; ++i) { *(LAS u32x4*)(Ks + ((skey + 64 * i) * KS_PITCH + sch * 8) * 2) = kreg[i]; *(LAS u32x4*)(Vs + ((skey + 64 * i) * VS_PITCH + sch * 8) * 2) = vreg[i]; }
        __syncthreads();
        int krow0n = 0, mtn = 0; const int tn = attn_next_tile(ti + 1, ctxq, blk, b, krow0n, mtn);
        if (tn < 5) {
#pragma unroll
            for (int i = 0; i < 2; ++i) { const bf16_t* rp = pxa + (size_t)(krow0n + skey + 64 * i) * PXW + kvh * 64 + sch * 8; kreg[i] = *(const u32x4*)(rp + C_AK); vreg[i] = *(const u32x4*)(rp + C_AV); } }
        attn_tile(mtype, Ks, Vs, qf, o, mrun, osum, th, c, g);
#if PROBE_ATT2
        attn_tile(mtype, Ks, Vs, qf, o, mrun, osum, th, c, g);
#endif
        ti = tn; krow0 = krow0n; mtype = mtn; cur ^= 1;
    }
    { u32x4 zr[8];
#pragma unroll
        for (int i = 0; i < 8; ++i) zr[i] = *(const u32x4*)(pxa + (size_t)(qrow0 + 8 * i + (f.lane >> 3)) * PXW + C_AZ + h * 64 + (f.lane & 7) * 8);
        __syncthreads();
        LAS unsigned char* wp = f.lds + f.wave * 9216;
#pragma unroll
        for (int qt = 0; qt < 4; ++qt) { const float inv = 1.f / osum[qt][0];
#pragma unroll
            for (int et = 0; et < 4; ++et) { const f32x4 ov = o[et][qt] * inv; u32x2 w; w.x = pk2(ov[0], ov[1]); w.y = pk2(ov[2], ov[3]);
                *(LAS u32x2*)(wp + ((qt * 16 + c) * 72 + et * 16 + 4 * g) * 2) = w; } }
        LDS_WAIT();
#pragma unroll
        for (int i = 0; i < 8; ++i) { const int q = 8 * i + (f.lane >> 3), ch8 = (f.lane & 7) * 8; const u32x4 ow = *(const LAS u32x4*)(wp + (q * 72 + ch8) * 2), z = zr[i]; u32x4 w;
            w.x = pk2(bf2f(ow.x & 0xffffu) * siluf(bf2f(z.x & 0xffffu)), bf2f(ow.x >> 16) * siluf(bf2f(z.x >> 16))); w.y = pk2(bf2f(ow.y & 0xffffu) * siluf(bf2f(z.y & 0xffffu)), bf2f(ow.y >> 16) * siluf(bf2f(z.y >> 16)));
            w.z = pk2(bf2f(ow.z & 0xffffu) * siluf(bf2f(z.z & 0xffffu)), bf2f(ow.z >> 16) * siluf(bf2f(z.z >> 16))); w.w = pk2(bf2f(ow.w & 0xffffu) * siluf(bf2f(z.w & 0xffffu)), bf2f(ow.w >> 16) * siluf(bf2f(z.w >> 16)));
            *(u32x4*)(Y + (size_t)(qrow0 + q) * YW + h * 64 + ch8) = w; } }
}

__device__ __forceinline__ void unit_publish_q(const F& f, unsigned* cnt, unsigned n = 1u) { if (REP_SUB >= 0 && f.dup) return; f.pend = cnt; f.pendn = n; }
__device__ __forceinline__ void unit_publish(const F& f, unsigned* cnt) {
    asm volatile("s_waitcnt vmcnt(0)" ::: "memory"); __syncthreads();
    if (REP_SUB >= 0 && f.dup) return;
    if (f.tid == 0) __hip_atomic_fetch_add(cnt, 1u, __ATOMIC_RELAXED, __HIP_MEMORY_SCOPE_AGENT);
}
__device__ __forceinline__ void st_wt8(void* q, const u32x2 v) { __hip_atomic_store((unsigned long long*)q, (unsigned long long)v.x | ((unsigned long long)v.y << 32), __ATOMIC_RELAXED, __HIP_MEMORY_SCOPE_AGENT); }
__device__ __forceinline__ void st_wt4(float* q, float v) { __hip_atomic_store((unsigned*)q, __builtin_bit_cast(unsigned, v), __ATOMIC_RELAXED, __HIP_MEMORY_SCOPE_AGENT); }
__device__ __forceinline__ void unit_poll(const F& f, unsigned* cnt, unsigned want) {
    if (f.tid == 0) { unsigned spins = 0; while (__hip_atomic_load(cnt, __ATOMIC_RELAXED, __HIP_MEMORY_SCOPE_AGENT) < want && ++spins < (1u << 22)) __builtin_amdgcn_s_sleep(2); }
    __syncthreads();
}
__device__ __forceinline__ unsigned poll_early(const F& f, unsigned* cnt) { unsigned v = 0u; if (f.tid == 0) v = __hip_atomic_load(cnt, __ATOMIC_RELAXED, __HIP_MEMORY_SCOPE_AGENT); return v; }
__device__ __forceinline__ void poll_finish(const F& f, unsigned* cnt, unsigned want, unsigned v0) {
    if (f.tid == 0 && v0 < want) { unsigned spins = 0; while (__hip_atomic_load(cnt, __ATOMIC_RELAXED, __HIP_MEMORY_SCOPE_AGENT) < want && ++spins < (1u << 22)) __builtin_amdgcn_s_sleep(2); }
    __syncthreads();
}
__device__ __forceinline__ void unit_wait(const F& f, unsigned* cnt, unsigned want) {
    if (f.tid == 0) { unsigned spins = 0;
        while (__hip_atomic_load(cnt, __ATOMIC_RELAXED, __HIP_MEMORY_SCOPE_AGENT) < want && ++spins < (1u << 22)) __builtin_amdgcn_s_sleep(2);
        __builtin_amdgcn_fence(__ATOMIC_ACQUIRE, "agent"); asm volatile("s_waitcnt vmcnt(0)" ::: "memory"); }
    __syncthreads();
}

__device__ __forceinline__ float lg2_gamma(const P& p, int l, int dir, int h) { const float dec = p.ret_decay[l * 8 + dir * 4 + h]; return -log1pf(expf(-dec)) * LOG2E; }
__device__ __forceinline__ void chunk_rows(int u, int& b, int& h, int& g, int& rows0) { g = u % 34; const int bh = u / 34; b = bh >> 2; h = bh & 3; rows0 = g < 2 ? LATROWS + b * L + g * 128 : b * S + (g - 2) * 128; }
__device__ __forceinline__ u32x4 scale8(const u32x4 v, float sc) { u32x4 w; w.x = pk2(bf2f(v.x & 0xffffu) * sc, bf2f(v.x >> 16) * sc); w.y = pk2(bf2f(v.y & 0xffffu) * sc, bf2f(v.y >> 16) * sc);
    w.z = pk2(bf2f(v.z & 0xffffu) * sc, bf2f(v.z >> 16) * sc); w.w = pk2(bf2f(v.w & 0xffffu) * sc, bf2f(v.w >> 16) * sc); return w; }
__device__ __forceinline__ void ret1_unit(const P& p, const F& f, int l, int up) {
    const bf16_t* pxa = (const bf16_t*)(p.ws + WS_PXA); float* incr = (float*)(p.ws + WS_INCR);
    LAS unsigned char* Kz = f.lds; LAS unsigned char* Vs = f.lds + 40960;
    const int c = f.lane & 15, g4 = f.lane >> 4;
    int b, h, gA, rowsA, gB, rowsB; chunk_rows(2 * up, b, h, gA, rowsA); { int b2, h2; chunk_rows(2 * up + 1, b2, h2, gB, rowsB); }
    const float l0 = lg2_gamma(p, l, 0, h), l1 = lg2_gamma(p, l, 1, h);
    u32x4 kvr[2][2], vvr[2][2];
#pragma unroll
    for (int q = 0; q < 2; ++q)
#pragma unroll
        for (int i = 0; i < 2; ++i) { const int idx = f.tid + i * NTHR, m = idx >> 3, ch = idx & 7; const bf16_t* rp = pxa + (size_t)((q ? rowsB : rowsA) + m) * PXW + h * 64 + ch * 8;
            kvr[q][i] = *(const u32x4*)(rp + C_RK); vvr[q][i] = *(const u32x4*)(rp + C_RV); }
#pragma unroll
    for (int q = 0; q < 2; ++q) { const int g = q ? gB : gA;
        __syncthreads();
#pragma unroll
        for (int i = 0; i < 2; ++i) { const int idx = f.tid + i * NTHR, m = idx >> 3, ch = idx & 7; const u32x4 kv = kvr[q][i], vv = vvr[q][i];
            *(LAS u32x4*)(Kz + (m * VS_PITCH + ch * 8) * 2) = scale8(kv, ex2(l0 * (float)(127 - m)));
            *(LAS u32x4*)(Kz + ((128 + m) * VS_PITCH + ch * 8) * 2) = scale8(kv, ex2(l1 * (float)m));
            *(LAS u32x4*)(Vs + (m * VS_PITCH + ch * 8) * 2) = vv; }
        __syncthreads();
        const int dir = f.wave >> 2, et = f.wave & 3;
        f32x4 acc[4];
#pragma unroll
        for (int dt = 0; dt < 4; ++dt) acc[dt] = (f32x4){0.f, 0.f, 0.f, 0.f};
        { bf16x8 vfr[4], kfr[4][4];
#pragma unroll
            for (int ks = 0; ks < 4; ++ks) { vfr[ks] = frag_tr8(Vs, VS_PITCH, ks * 32, et * 16, c, g4);
#pragma unroll
                for (int dt = 0; dt < 4; ++dt) kfr[ks][dt] = frag_tr8(Kz + dir * 20480, VS_PITCH, ks * 32, dt * 16, c, g4); }
            __builtin_amdgcn_sched_barrier(0);
#pragma unroll
            for (int ks = 0; ks < 4; ++ks)
#pragma unroll
                for (int dt = 0; dt < 4; ++dt) acc[dt] = MFMA16(vfr[ks], kfr[ks][dt], acc[dt]); }
        float* op = incr + ((size_t)(((b * 4 + h) * 34 + g) * 2 + dir)) * 4096;
        { LAS float* wp = (LAS float*)(f.lds + 61440 + f.wave * 4096);
#pragma unroll
            for (int dt = 0; dt < 4; ++dt)
#pragma unroll
                for (int r = 0; r < 4; ++r) wp[(4 * g4 + r) * 64 + dt * 16 + c] = acc[dt][r];
            LDS_WAIT();
#pragma unroll
            for (int i = 0; i < 4; ++i) { const f32x4 v = *(const LAS f32x4*)(wp + i * 256 + f.lane * 4);
                st_wt16((void*)(p.ws + WS_INCR), (size_t)NB * 4 * 34 * 2 * 4096 * 4, (unsigned)(((op - incr) + et * 1024 + i * 256 + f.lane * 4) * 4), __builtin_bit_cast(u32x4, v)); }
            LDS_WAIT(); }
    }
    unit_publish_q(f, (unsigned*)(p.ws + WS_CTL) + CW_RC + (l * 16 + b * 4 + h) * 16, 2u);
}
__device__ __forceinline__ void scan_unit(const P& p, const F& f, int l, int u) {
    const int half = u & 1, dir = (u >> 1) & 1, bh = u >> 2;
    const float* incr = (const float*)(p.ws + WS_INCR) + ((size_t)(bh * 34) * 2 + dir) * 4096; bf16_t* st = (bf16_t*)(p.ws + WS_STATE) + ((size_t)(bh * 34) * 2 + dir) * 4096;
    unit_poll(f, (unsigned*)(p.ws + WS_CTL) + CW_RC + (l * 16 + bh) * 16, 34u);
    const float G = ex2(lg2_gamma(p, l, dir, bh & 3) * 128.f);
    const int eo = (half * 32 + (f.tid >> 4)) * 64 + (f.tid & 15) * 4;
    f32x4 R = {0.f, 0.f, 0.f, 0.f};
#pragma unroll 1
    for (int j0 = 0; j0 < 34; j0 += 17) { f32x4 v[17];
#pragma unroll
        for (int j = 0; j < 17; ++j) { const int jj = j0 + j, gp = dir == 0 ? jj : (jj < 2 ? 1 - jj : 35 - jj); v[j] = *(const f32x4*)(incr + (size_t)gp * 8192 + eo); }
#pragma unroll
        for (int j = 0; j < 17; ++j) { const int jj = j0 + j, gp = dir == 0 ? jj : (jj < 2 ? 1 - jj : 35 - jj);
            u32x2 w; w.x = pk2(R[0], R[1]); w.y = pk2(R[2], R[3]); st_wt8(st + (size_t)gp * 8192 + eo, w); R = R * G + v[j]; } }
    unit_publish_q(f, (unsigned*)(p.ws + WS_CTL) + CW_SC + (l * 16 + bh) * 16);
}
__device__ __forceinline__ void ret2_unit(const P& p, const F& f, int l, int u) {
    const bf16_t* pxa = (const bf16_t*)(p.ws + WS_PXA); const bf16_t* stt = (const bf16_t*)(p.ws + WS_STATE); bf16_t* Y = (bf16_t*)(p.ws + WS_Y);
    LAS unsigned char* RT = f.lds; LAS unsigned char* Qx = f.lds + 18432; LAS unsigned char* Ks = f.lds + 55296; LAS unsigned char* Vs = f.lds + 73728;
    const int c = f.lane & 15, g4 = f.lane >> 4;
    {
        int b, h, g, rows0; chunk_rows(u, b, h, g, rows0);
        const float l0 = lg2_gamma(p, l, 0, h), l1 = lg2_gamma(p, l, 1, h);
        unsigned* sccnt = (unsigned*)(p.ws + WS_CTL) + CW_SC + (l * 16 + b * 4 + h) * 16; const unsigned scv = poll_early(f, sccnt);
        u32x4 qv[2], kv[2], vv[2];
#pragma unroll
        for (int i = 0; i < 2; ++i) { const int idx = f.tid + i * NTHR, m = idx >> 3, ch = idx & 7; const bf16_t* rp = pxa + (size_t)(rows0 + m) * PXW + h * 64 + ch * 8;
            qv[i] = *(const u32x4*)(rp + C_RQ); kv[i] = *(const u32x4*)(rp + C_RK); vv[i] = *(const u32x4*)(rp + C_RV); }
        u32x2 zq[4];
#pragma unroll
        for (int et = 0; et < 4; ++et) zq[et] = *(const u32x2*)(pxa + (size_t)(rows0 + f.wave * 16 + c) * PXW + C_RZ + h * 64 + et * 16 + 4 * g4);
        poll_finish(f, sccnt, 4u, scv);
        unsigned long long stl[2][2];
#pragma unroll
        for (int i = 0; i < 2; ++i) { const int idx = f.tid + i * NTHR, dir = idx >> 9, e = (idx >> 3) & 63, d8 = (idx & 7) * 8;
            const unsigned long long* sp = (const unsigned long long*)(stt + ((size_t)(((b * 4 + h) * 34 + g) * 2 + dir)) * 4096 + e * 64 + d8);
            stl[i][0] = __hip_atomic_load(sp, __ATOMIC_RELAXED, __HIP_MEMORY_SCOPE_AGENT); stl[i][1] = __hip_atomic_load(sp + 1, __ATOMIC_RELAXED, __HIP_MEMORY_SCOPE_AGENT); }
#pragma unroll
        for (int i = 0; i < 2; ++i) { const int idx = f.tid + i * NTHR, dir = idx >> 9, e = (idx >> 3) & 63, d8 = (idx & 7) * 8; const unsigned long long lo = stl[i][0], hi2 = stl[i][1];
            u32x4 w; w.x = (unsigned)lo; w.y = (unsigned)(lo >> 32); w.z = (unsigned)hi2; w.w = (unsigned)(hi2 >> 32); *(LAS u32x4*)(RT + ((dir * 64 + e) * KS_PITCH + d8) * 2) = w; }
#pragma unroll
        for (int i = 0; i < 2; ++i) { const int idx = f.tid + i * NTHR, m = idx >> 3, ch = idx & 7;
            *(LAS u32x4*)(Ks + (m * KS_PITCH + ch * 8) * 2) = kv[i];
            *(LAS u32x4*)(Qx + (m * KS_PITCH + ch * 8) * 2) = scale8(qv[i], ex2(l0 * (float)(m + 1)));
            *(LAS u32x4*)(Qx + ((128 + m) * KS_PITCH + ch * 8) * 2) = scale8(qv[i], ex2(l1 * (float)(128 - m)));
            *(LAS u32x4*)(Vs + (m * VS_PITCH + ch * 8) * 2) = vv[i]; }
        LAS float* dtab = (LAS float*)(f.lds + 94208);
        if (f.tid < 255) { const int dd = f.tid - 127; dtab[f.tid] = (dd >= 0 ? ex2(l0 * (float)dd) : 0.f) + (dd <= 0 ? ex2(-l1 * (float)dd) : 0.f); }
        __syncthreads();
        const int ct = f.wave;
        f32x4 s[8];
#pragma unroll
        for (int mt = 0; mt < 8; ++mt) s[mt] = (f32x4){0.f, 0.f, 0.f, 0.f};
        { bf16x8 qfr[2], kfr[2][8];
#pragma unroll
            for (int ks = 0; ks < 2; ++ks) { qfr[ks] = *(const LAS bf16x8*)(Qx + ((ct * 16 + c) * KS_PITCH + ks * 32 + 8 * g4) * 2);
#pragma unroll
                for (int mt = 0; mt < 8; ++mt) kfr[ks][mt] = *(const LAS bf16x8*)(Ks + ((mt * 16 + c) * KS_PITCH + ks * 32 + 8 * g4) * 2); }
            __builtin_amdgcn_sched_barrier(0);
#pragma unroll
            for (int ks = 0; ks < 2; ++ks)
#pragma unroll
                for (int mt = 0; mt < 8; ++mt) s[mt] = MFMA16(kfr[ks][mt], qfr[ks], s[mt]); }
        const int cidx = ct * 16 + c; const float ixi = ex2(-l0 * (float)(cidx + 1));
#pragma unroll
        for (int mt = 0; mt < 8; ++mt)
#pragma unroll
            for (int r = 0; r < 4; ++r) { const int dd = cidx - (mt * 16 + 4 * g4 + r); s[mt][r] *= dtab[dd + 127] * ixi; }
        f32x4 o[4];
#pragma unroll
        for (int et = 0; et < 4; ++et) o[et] = (f32x4){0.f, 0.f, 0.f, 0.f};
        { bf16x8 vfr[4][4];
#pragma unroll
            for (int kb = 0; kb < 4; ++kb)
#pragma unroll
                for (int et = 0; et < 4; ++et) vfr[kb][et] = frag_tr_pv(Vs, VS_PITCH, kb * 32, et * 16, c, g4);
            __builtin_amdgcn_sched_barrier(0);
#pragma unroll
            for (int kb = 0; kb < 4; ++kb) { const f32x4 a = s[2 * kb], bq = s[2 * kb + 1]; u32x4 w; w.x = pk2(a[0], a[1]); w.y = pk2(a[2], a[3]); w.z = pk2(bq[0], bq[1]); w.w = pk2(bq[2], bq[3]);
                const bf16x8 pf = __builtin_bit_cast(bf16x8, w);
#pragma unroll
                for (int et = 0; et < 4; ++et) o[et] = MFMA16(vfr[kb][et], pf, o[et]); } }
        { bf16x8 qxf[2][2], rf[2][2][4];
#pragma unroll
            for (int dir = 0; dir < 2; ++dir)
#pragma unroll
                for (int ks = 0; ks < 2; ++ks) { qxf[dir][ks] = *(const LAS bf16x8*)(Qx + ((dir * 128 + ct * 16 + c) * KS_PITCH + ks * 32 + 8 * g4) * 2);
#pragma unroll
                    for (int et = 0; et < 4; ++et) rf[dir][ks][et] = *(const LAS bf16x8*)(RT + ((dir * 64 + et * 16 + c) * KS_PITCH + ks * 32 + 8 * g4) * 2); }
            __builtin_amdgcn_sched_barrier(0);
#pragma unroll
            for (int dir = 0; dir < 2; ++dir)
#pragma unroll
                for (int ks = 0; ks < 2; ++ks)
#pragma unroll
                    for (int et = 0; et < 4; ++et) o[et] = MFMA16(rf[dir][ks][et], qxf[dir][ks], o[et]); }
        float sm = 0.f;
#pragma unroll
        for (int et = 0; et < 4; ++et) sm += (o[et][0] + o[et][1]) + (o[et][2] + o[et][3]);
        sm = rows_sum(sm);
        const float mu = sm * (1.f / 64.f); float q = 0.f;
#pragma unroll
        for (int et = 0; et < 4; ++et) { o[et] = o[et] - mu; q += (o[et][0] * o[et][0] + o[et][1] * o[et][1]) + (o[et][2] * o[et][2] + o[et][3] * o[et][3]); }
        q = rows_sum(q);
        const float rs = rsqrtf(q * (1.f / 64.f) + EPS); const size_t row = (size_t)(rows0 + cidx);
#pragma unroll
        for (int et = 0; et < 4; ++et) { const int col = h * 64 + et * 16 + 4 * g4; const u32x2 zw = zq[et]; const f32x4 ov = o[et] * rs; u32x2 w;
            w.x = pk2(ov[0] * siluf(bf2f(zw.x & 0xffffu)), ov[1] * siluf(bf2f(zw.x >> 16))); w.y = pk2(ov[2] * siluf(bf2f(zw.y & 0xffffu)), ov[3] * siluf(bf2f(zw.y >> 16)));
            *(u32x2*)(Y + row * YW + 768 + col) = w; }
    }
}

constexpr int FX_PITCH = 272, FA_PITCH = 136, LDS_TRIG = 161232, LDS_FA = 126416, LDS_FA2 = 109008, LDS_FC = 77824;
template <class RowPtr> __device__ __forceinline__ void fft_stage(const F& f, RowPtr rp) {
    u32x4 v[8];
#pragma unroll
    for (int i = 0; i < 8; ++i) { const int idx = f.tid + i * NTHR, kr = idx >> 5, chunk = idx & 31; v[i] = *(const u32x4*)(rp(kr) + chunk * 8); }
    __builtin_amdgcn_sched_barrier(0);
#pragma unroll
    for (int i = 0; i < 8; ++i) { const int idx = f.tid + i * NTHR, kr = idx >> 5, chunk = idx & 31; *(LAS u32x4*)(f.lds + (kr * FX_PITCH + chunk * 8) * 2) = v[i]; }
}
template <int MT> __device__ __forceinline__ void fft_mma(const F& f, const int LDS_A, f32x4 (&acc)[2][MT]) {
    const int c = f.lane & 15, g4 = f.lane >> 4;
    bf16x8 bf[2][2], af[2][MT];
#define FFT_RD(ks, q) do { _Pragma("unroll") for (int nt = 0; nt < 2; ++nt) bf[q][nt] = frag_tr8(f.lds, FX_PITCH, (ks) * 32, f.wave * 32 + nt * 16, c, g4); \
        _Pragma("unroll") for (int mt = 0; mt < MT; ++mt) af[q][mt] = *(const LAS bf16x8*)(f.lds + LDS_A + ((mt * 16 + c) * FA_PITCH + (ks) * 32 + 8 * g4) * 2); } while (0)
    FFT_RD(0, 0);
#pragma unroll
    for (int ks = 0; ks < 4; ++ks) { const int q = ks & 1;
        if (ks < 3) { FFT_RD(ks + 1, q ^ 1); }
        __builtin_amdgcn_sched_barrier(0);
#pragma unroll
        for (int mt = 0; mt < MT; ++mt)
#pragma unroll
            for (int nt = 0; nt < 2; ++nt) acc[nt][mt] = MFMA16(bf[q][nt], af[q][mt], acc[nt][mt]);
        __builtin_amdgcn_sched_barrier(0); }
#undef FFT_RD
}
__device__ __forceinline__ void fft_trig(const F& f) {
    LAS float* tg = (LAS float*)(f.lds + LDS_TRIG);
    if (f.tid < 64) { tg[f.tid] = cospif(f.tid / 32.f); tg[64 + f.tid] = sinpif(f.tid / 32.f); }
    if (f.tid < 256) { tg[128 + f.tid] = cospif(f.tid / 128.f); tg[384 + f.tid] = sinpif(f.tid / 128.f); }
}
__device__ __forceinline__ void fft1_setup(const P& p, const F& f) {
    __syncthreads(); fft_trig(f);
    for (int e = f.tid; e < 34816 / 16; e += NTHR) *(LAS u32x4*)(f.lds + LDS_FA + e * 16) = *(const u32x4*)(p.ws + WS_FA1 + e * 16);
    __syncthreads();
}
__device__ __forceinline__ void fft1_unit(const P& p, const F& f, int l, int u) {
    const bf16_t* pxa = (const bf16_t*)(p.ws + WS_PXA); bf16_t* GP = (bf16_t*)(p.ws + WS_GP);
    const int c = f.lane & 15, g4 = f.lane >> 4;
    { const int b = u >> 6, n2 = u & 63;
        __syncthreads();
        fft_stage(f, [&](int kr) { return pxa + (size_t)(b * S + 64 * (kr & 63) + n2) * PXW + ((kr >> 6) ? C_FS : C_FC); });
        __syncthreads();
        f32x4 acc[2][8];
#pragma unroll
        for (int nt = 0; nt < 2; ++nt)
#pragma unroll
            for (int mt = 0; mt < 8; ++mt) acc[nt][mt] = (f32x4){0.f, 0.f, 0.f, 0.f};
        fft_mma<8>(f, LDS_FA, acc);
        __syncthreads();
        constexpr int OP_ = 264;
#pragma unroll
        for (int mt = 0; mt < 4; ++mt) { const int k1 = mt * 16 + c; const float ang = (float)(n2 * k1) * (1.f / 2048.f), cw = cospif(ang), sw = sinpif(ang);
#pragma unroll
            for (int nt = 0; nt < 2; ++nt) { const f32x4 gr = acc[nt][mt], gi = acc[nt][mt + 4], pr = gr * cw + gi * sw, pi = gi * cw - gr * sw;
                const int ch = f.wave * 32 + nt * 16 + 4 * g4;
                u32x2 w; w.x = pk2(pr[0], pr[1]); w.y = pk2(pr[2], pr[3]); *(LAS u32x2*)(f.lds + (k1 * OP_ + ch) * 2) = w;
                w.x = pk2(pi[0], pi[1]); w.y = pk2(pi[2], pi[3]); *(LAS u32x2*)(f.lds + ((64 + k1) * OP_ + ch) * 2) = w; } }
        __syncthreads();
#pragma unroll
        for (int i = 0; i < 8; ++i) { const int idx = f.tid + i * NTHR, row = idx >> 5, chunk = idx & 31; const u32x4 v = *(const LAS u32x4*)(f.lds + (row * OP_ + chunk * 8) * 2);
            st_wt16(GP, (size_t)NB * 64 * 2 * 64 * 256 * 2, (unsigned)((((size_t)((b * 64 + (row & 63)) * 2 + (row >> 6)) * 64 + n2) * 256 + chunk * 8) * 2), v); }
        unit_publish_q(f, (unsigned*)(p.ws + WS_CTL) + CW_F1 + (l * 4 + b) * 16);
    }
}
__device__ __forceinline__ void fft2_setup(const P& p, const F& f) {
    __syncthreads(); fft_trig(f);
    for (int e = f.tid; e < 17408 / 16; e += NTHR) *(LAS u32x4*)(f.lds + LDS_FA2 + e * 16) = *(const u32x4*)(p.ws + WS_FA2 + e * 16);
    __syncthreads();
}
__device__ __forceinline__ void fft2_unit(const P& p, const F& f, int l, int u) {
    const bf16_t* pxa = (const bf16_t*)(p.ws + WS_PXA); const bf16_t* GP = (const bf16_t*)(p.ws + WS_GP); bf16_t* Y = (bf16_t*)(p.ws + WS_Y);
    const int c = f.lane & 15, g4 = f.lane >> 4;
    { const int b = u >> 6, k1 = u & 63;
        unsigned* f1cnt = (unsigned*)(p.ws + WS_CTL) + CW_F1 + (l * 4 + b) * 16; const unsigned f1v = poll_early(f, f1cnt);
        u32x4 zr[4];
#pragma unroll
        for (int i = 0; i < 4; ++i) { const int idx = f.tid + i * NTHR, k2 = idx >> 5, ch8 = (idx & 31) * 8; zr[i] = *(const u32x4*)(pxa + (size_t)(b * S + 64 * k2 + k1) * PXW + C_FZ + ch8); }
        poll_finish(f, f1cnt, 64u, f1v);
        fft_stage(f, [&](int kr) { return GP + ((size_t)(b * 64 + k1) * 128 + kr) * 256; });
        __syncthreads();
        f32x4 acc[2][4];
#pragma unroll
        for (int nt = 0; nt < 2; ++nt)
#pragma unroll
            for (int mt = 0; mt < 4; ++mt) acc[nt][mt] = (f32x4){0.f, 0.f, 0.f, 0.f};
        fft_mma<4>(f, LDS_FA2, acc);
        __syncthreads();
        constexpr int OP_ = 264;
#pragma unroll
        for (int mt = 0; mt < 4; ++mt)
#pragma unroll
            for (int nt = 0; nt < 2; ++nt) *(LAS f32x4*)(f.lds + ((mt * 16 + c) * OP_ + f.wave * 32 + nt * 16 + 4 * g4) * 4) = acc[nt][mt] * (1.f / 512.f);
        __syncthreads();
#pragma unroll
        for (int i = 0; i < 4; ++i) { const int idx = f.tid + i * NTHR, k2 = idx >> 5, ch8 = (idx & 31) * 8;
            const f32x4 o0 = *(const LAS f32x4*)(f.lds + (k2 * OP_ + ch8) * 4), o1 = *(const LAS f32x4*)(f.lds + (k2 * OP_ + ch8 + 4) * 4); const u32x4 z = zr[i]; u32x4 w;
            w.x = pk2(o0[0] * siluf(bf2f(z.x & 0xffffu)), o0[1] * siluf(bf2f(z.x >> 16))); w.y = pk2(o0[2] * siluf(bf2f(z.y & 0xffffu)), o0[3] * siluf(bf2f(z.y >> 16)));
            w.z = pk2(o1[0] * siluf(bf2f(z.z & 0xffffu)), o1[1] * siluf(bf2f(z.z >> 16))); w.w = pk2(o1[2] * siluf(bf2f(z.w & 0xffffu)), o1[3] * siluf(bf2f(z.w >> 16)));
            *(u32x4*)(Y + (size_t)(b * S + 64 * k2 + k1) * YW + 1024 + ch8) = w; }
    }
}
__device__ __forceinline__ void fctx_unit(const P& p, const F& f, int u) {
    const bf16_t* pxa = (const bf16_t*)(p.ws + WS_PXA); bf16_t* Y = (bf16_t*)(p.ws + WS_Y);
    LAS bf16_t* As = (LAS bf16_t*)(f.lds + LDS_FC); const LAS float* tg = (const LAS float*)(f.lds + LDS_TRIG);
    const int c = f.lane & 15, g4 = f.lane >> 4;
    { const int b = u >> 4, kb = u & 15;
        f32x4 acc[2][1];
        acc[0][0] = (f32x4){0.f, 0.f, 0.f, 0.f}; acc[1][0] = acc[0][0];
        for (int pass = 0; pass < 4; ++pass) {
            __syncthreads();
            for (int e = f.tid; e < 16 * 128; e += NTHR) { const int ko = e >> 7, k = e & 127, ip = k >> 6, n = pass * 64 + (k & 63), ph = ((kb * 16 + ko) * n) & 255;
                As[ko * FA_PITCH + k] = (bf16_t)f2bf(ip == 0 ? tg[128 + ph] : -tg[384 + ph]); }
            fft_stage(f, [&](int kr) { return pxa + (size_t)(LATROWS + b * L + pass * 64 + (kr & 63)) * PXW + ((kr >> 6) ? C_FS : C_FC); });
            __syncthreads();
            fft_mma<1>(f, LDS_FC, acc);
        }
        const size_t row = (size_t)(LATROWS + b * L + kb * 16 + c);
#pragma unroll
        for (int nt = 0; nt < 2; ++nt) { const int ch = f.wave * 32 + nt * 16 + 4 * g4; const u32x2 zw = *(const u32x2*)(pxa + row * PXW + C_FZ + ch); const f32x4 ov = acc[nt][0] * (1.f / 128.f); u32x2 w;
            w.x = pk2(ov[0] * siluf(bf2f(zw.x & 0xffffu)), ov[1] * siluf(bf2f(zw.x >> 16))); w.y = pk2(ov[2] * siluf(bf2f(zw.y & 0xffffu)), ov[3] * siluf(bf2f(zw.y >> 16)));
            *(u32x2*)(Y + row * YW + 1024 + ch) = w; }
    }
}


__device__ __forceinline__ void panel_rs(unsigned char* wsb, int l, int which, int pm, int pn, int wr, int wc, int fr, int fq, int tid, LAS unsigned char* lds, const float (&part)[8]) {
    LAS float* Pt = (LAS float*)lds; LAS float* St = (LAS float*)(lds + 4096);
    if (fq == 0) {
#pragma unroll
        for (int i = 0; i < 8; ++i) Pt[((i >> 2) * 128 + wr * 64 + (i & 3) * 16 + fr) * 4 + wc] = part[i]; }
    __syncthreads();
    float* slots = (float*)(wsb + WS_SX) + (size_t)which * LATROWS * 4 + (size_t)pm * 256 * 4;
    unsigned* cnt = (unsigned*)(wsb + WS_CTL) + CW_PX + ((l * 2 + which) * 64 + pm) * 16;
    if (tid < 256) st_wt4(slots + tid * 4 + pn, (Pt[tid * 4] + Pt[tid * 4 + 1]) + (Pt[tid * 4 + 2] + Pt[tid * 4 + 3]));
    asm volatile("s_waitcnt vmcnt(0)" ::: "memory"); __syncthreads();
    if (tid == 0) { __hip_atomic_fetch_add(cnt, 1u, __ATOMIC_RELAXED, __HIP_MEMORY_SCOPE_AGENT); unsigned spins = 0;
        while (__hip_atomic_load(cnt, __ATOMIC_RELAXED, __HIP_MEMORY_SCOPE_AGENT) < 4u && ++spins < (1u << 22)) __builtin_amdgcn_s_sleep(1); }
    __syncthreads();
    if (tid < 256) { const unsigned long long* q = (const unsigned long long*)(slots + tid * 4);
        const unsigned long long a = __hip_atomic_load(q, __ATOMIC_RELAXED, __HIP_MEMORY_SCOPE_AGENT), b2 = __hip_atomic_load(q + 1, __ATOMIC_RELAXED, __HIP_MEMORY_SCOPE_AGENT);
        const float t = (__builtin_bit_cast(float, (unsigned)a) + __builtin_bit_cast(float, (unsigned)(a >> 32))) + (__builtin_bit_cast(float, (unsigned)b2) + __builtin_bit_cast(float, (unsigned)(b2 >> 32)));
        St[tid] = rsqrtf(t * (1.f / D) + EPS); }
    __syncthreads();
}
template <int LK> struct EpiOutFused {
    static constexpr bool PERM = true, AFTER_DRAIN = true, KEEP = false;
    const float* x; float* out; unsigned char* ws; const float* norm_post; const float* norm_pre; int l;
    __device__ __forceinline__ void fused(f32x4 (&acc)[2][2][4][2], const Unit& u, int wr, int wc, int fr, int fq, LAS unsigned char* lds, int wid, int lane) const {
        const int pm = u.pm, pn = u.pn, tid = wid * 64 + lane; constexpr bool last = LK == 2, first = LK == 0;
        int row0 = pm * 256 + wr * 64 + fr, col0 = pn * 256 + wc * 32 + 8 * fq;
        asm volatile("" : "+v"(row0), "+v"(col0));
        unsigned char* xbl = ws + WS_XB + ((size_t)((pm * 4 + pn) * 8 + wid) * 16) * 1024 + lane * 16;
        constexpr int XR = 4;
        u32x4 xw[XR];
#define XOFF(k) ((size_t)(row0 + (((k) & 7) >> 2) * 128 + ((k) & 3) * 16) * D + col0 + ((k) >> 3) * 128)
        if (!first) {
#pragma unroll
            for (int k = 0; k < XR; ++k) xw[k] = __builtin_nontemporal_load((const u32x4*)(xbl + ((k & 7) * 2 + (k >> 3)) * 1024)); }
        else {
#pragma unroll
            for (int k = 0; k < 2; ++k) { xw[2 * k] = __builtin_nontemporal_load((const u32x4*)(x + XOFF(k))); xw[2 * k + 1] = __builtin_nontemporal_load((const u32x4*)(x + XOFF(k) + 4)); } }
        float pcw = 0.f, pcs = 0.f, pch = 0.f;
        if (tid < 256) { const int pc = pn * 256 + tid; const float* modl_ = (const float*)(ws + WS_MOD) + ((size_t)l * 5 + (pm >> 4)) * 3 * D;
            pcw = modl_[2 * D + pc] * norm_post[l * D + pc];
            if (!last) { const float* modn_ = (const float*)(ws + WS_MOD) + ((size_t)(l + 1) * 5 + (pm >> 4)) * 3 * D; pcs = (modn_[D + pc] + 1.f) * norm_pre[(l + 1) * D + pc]; pch = modn_[pc]; } }
        float part[8]; const LAS float* St = (const LAS float*)(lds + 4096) + wr * 64 + fr;
#pragma unroll
        for (int i = 0; i < 8; ++i) { const int ai = i >> 2, m = i & 3; float ss = 0.f;
#pragma unroll
            for (int bj = 0; bj < 2; ++bj) { const f32x4 v0 = acc[ai][bj][m][0], v1 = acc[ai][bj][m][1];
                ss += (v0[0] * v0[0] + v0[1] * v0[1]) + (v0[2] * v0[2] + v0[3] * v0[3]) + (v1[0] * v1[0] + v1[1] * v1[1]) + (v1[2] * v1[2] + v1[3] * v1[3]); }
            part[i] = rows_sum(ss); }
        if (tid < 256) { LAS float* pp = (LAS float*)(lds + 6144); pp[tid] = pcw; pp[256 + tid] = pcs; pp[512 + tid] = pch; }
        panel_rs(ws, l, 0, pm, pn, wr, wc, fr, fq, tid, lds, part);
        const LAS float* pcol = (const LAS float*)(lds + 6144) + wc * 32 + 8 * fq;
#pragma unroll
        for (int bj = 0; bj < 2; ++bj) { const int col = col0 + bj * 128;
            const f32x4 w0 = *(const LAS f32x4*)(pcol + bj * 128), w1 = *(const LAS f32x4*)(pcol + bj * 128 + 4);
#pragma unroll
            for (int i = 0; i < 8; ++i) { const int ai = i >> 2, m = i & 3; const size_t off = (size_t)(row0 + ai * 128 + m * 16) * D + col;
                f32x4 x0, x1; const int k = bj * 8 + i;
                if (first) { const int q = (k & 1) * 2; x0 = __builtin_bit_cast(f32x4, xw[q]); x1 = __builtin_bit_cast(f32x4, xw[q + 1]);
                    if (k + 2 < 16) { xw[q] = __builtin_nontemporal_load((const u32x4*)(x + XOFF(k + 2))); xw[q + 1] = __builtin_nontemporal_load((const u32x4*)(x + XOFF(k + 2) + 4)); } }
                else { const u32x4 xq = xw[k % XR]; if (k + XR < 16) xw[k % XR] = __builtin_nontemporal_load((const u32x4*)(xbl + (((k + XR) & 7) * 2 + ((k + XR) >> 3)) * 1024)); x0 = (f32x4){bf2f(xq.x & 0xffffu), bf2f(xq.x >> 16), bf2f(xq.y & 0xffffu), bf2f(xq.y >> 16)}; x1 = (f32x4){bf2f(xq.z & 0xffffu), bf2f(xq.z >> 16), bf2f(xq.w & 0xffffu), bf2f(xq.w >> 16)}; }
                const float rsi = St[ai * 128 + m * 16]; const f32x4 v0 = x0 + w0 * (acc[ai][bj][m][0] * rsi), v1 = x1 + w1 * (acc[ai][bj][m][1] * rsi);
                acc[ai][bj][m][0] = v0; acc[ai][bj][m][1] = v1;
                if (last) { __builtin_nontemporal_store(v0, (f32x4*)(out + off)); __builtin_nontemporal_store(v1, (f32x4*)(out + off + 4)); }
                else { u32x4 w; w.x = pk2(v0[0], v0[1]); w.y = pk2(v0[2], v0[3]); w.z = pk2(v1[0], v1[1]); w.w = pk2(v1[2], v1[3]); __builtin_nontemporal_store(w, (u32x4*)(xbl + (i * 2 + bj) * 1024)); }
                } }
#undef XOFF
        if (last) return;
#pragma unroll
        for (int i = 0; i < 8; ++i) { const int ai = i >> 2, m = i & 3; float ss = 0.f;
#pragma unroll
            for (int bj = 0; bj < 2; ++bj) { const f32x4 v0 = acc[ai][bj][m][0], v1 = acc[ai][bj][m][1];
                ss += (v0[0] * v0[0] + v0[1] * v0[1]) + (v0[2] * v0[2] + v0[3] * v0[3]) + (v1[0] * v1[0] + v1[1] * v1[1]) + (v1[2] * v1[2] + v1[3] * v1[3]); }
            part[i] = rows_sum(ss); }
        panel_rs(ws, l, 1, pm, pn, wr, wc, fr, fq, tid, lds, part);
        const float* modn = (const float*)(ws + WS_MOD) + ((size_t)(l + 1) * 5 + (pm >> 4)) * 3 * D; bf16_t* hx = hxbuf(ws, l + 1);
#pragma unroll
        for (int bj = 0; bj < 2; ++bj) { const int col = col0 + bj * 128;
            const f32x4 s0 = *(const LAS f32x4*)(pcol + 256 + bj * 128), s1 = *(const LAS f32x4*)(pcol + 256 + bj * 128 + 4), h0 = *(const LAS f32x4*)(pcol + 512 + bj * 128), h1 = *(const LAS f32x4*)(pcol + 512 + bj * 128 + 4);
#pragma unroll
            for (int i = 0; i < 8; ++i) { const int ai = i >> 2, m = i & 3; const size_t off = (size_t)(row0 + ai * 128 + m * 16) * D + col;
                const float rsi = St[ai * 128 + m * 16]; const f32x4 a0 = acc[ai][bj][m][0] * rsi * s0 + h0, a1 = acc[ai][bj][m][1] * rsi * s1 + h1;
                u32x4 w; w.x = pk2(a0[0], a0[1]); w.y = pk2(a0[2], a0[3]); w.z = pk2(a1[0], a1[1]); w.w = pk2(a1[2], a1[3]); st_wt16(hx, (size_t)MROWS * D * 2, (unsigned)(off * 2), w); } }
        pg8::wave_publish((unsigned*)(ws + WS_CTL) + CW_HP + ((l + 1) * 80 + pm) * 16);
    }
};

template <int MODE> __device__ __forceinline__ void gemm64_unit(const P& p, const F& f, const bf16_t* A, const bf16_t* Bt, int ld, int K, int row0, int col0, bf16_t* outbase = nullptr) {
    constexpr int GP_ = 264, GB_ = 64 * GP_ * 2;
    const int c = f.lane & 15, g4 = f.lane >> 4, m0 = (f.wave & 3) * 16, n0 = (f.wave >> 2) * 32;
    const int sr = f.tid >> 5, sc = (f.tid & 31) * 8;
    const bf16_t* ap = A + (size_t)(row0 + sr) * ld + sc; const bf16_t* bp = Bt + (size_t)(col0 + sr) * ld + sc;
    u32x4 ra[4], rb[4];
#pragma unroll
    for (int i = 0; i < 4; ++i) { ra[i] = *(const u32x4*)(ap + (size_t)(16 * i) * ld); rb[i] = *(const u32x4*)(bp + (size_t)(16 * i) * ld); }
    f32x4 acc[2] = {{0.f, 0.f, 0.f, 0.f}, {0.f, 0.f, 0.f, 0.f}};
    unsigned gpl[4][2] = {{0u, 0u}, {0u, 0u}, {0u, 0u}, {0u, 0u}};
    if (MODE == 0) { const int row = row0 + m0 + c, rr = row & 255;
        const unsigned char* gp = (const unsigned char*)(p.ws + WS_GATES) + ((size_t)(row >> 8) * 16) * 65536 + ((rr >> 6) & 1) * 32768 + ((rr >> 7) * 4 + ((rr >> 4) & 3)) * 1024 + (rr & 15) * 16;
#pragma unroll
        for (int nt = 0; nt < 2; ++nt) { const int ch = col0 + n0 + nt * 16 + 4 * g4, cc = ch & 255;
            const unsigned char* gq = gp + (size_t)(ch >> 8) * 262144 + ((cc >> 5) & 3) * 8192 + ((cc >> 3) & 3) * 256 + (cc >> 7) * 8 + ((cc >> 2) & 1) * 4;
#pragma unroll
            for (int br = 0; br < 4; ++br) gpl[br][nt] = *(const unsigned*)(gq + br * 65536); } }
    const int nch = K >> 8; int cur = 0;
    __syncthreads();
    for (int kc = 0; kc < nch; ++kc) {
        LAS unsigned char* As = f.lds + cur * (2 * GB_); LAS unsigned char* Bs = As + GB_;
#pragma unroll
        for (int i = 0; i < 4; ++i) { *(LAS u32x4*)(As + ((sr + 16 * i) * GP_ + sc) * 2) = ra[i]; *(LAS u32x4*)(Bs + ((sr + 16 * i) * GP_ + sc) * 2) = rb[i]; }
        __syncthreads();
        if (kc + 1 < nch) {
#pragma unroll
            for (int i = 0; i < 4; ++i) { ra[i] = *(const u32x4*)(ap + (size_t)(16 * i) * ld + (kc + 1) * 256); rb[i] = *(const u32x4*)(bp + (size_t)(16 * i) * ld + (kc + 1) * 256); } }
        bf16x8 afr[8], bfr[8][2];
#pragma unroll
        for (int ks = 0; ks < 8; ++ks) { afr[ks] = *(const LAS bf16x8*)(As + ((m0 + c) * GP_ + ks * 32 + 8 * g4) * 2);
#pragma unroll
            for (int nt = 0; nt < 2; ++nt) bfr[ks][nt] = *(const LAS bf16x8*)(Bs + ((n0 + nt * 16 + c) * GP_ + ks * 32 + 8 * g4) * 2); }
        __builtin_amdgcn_sched_barrier(0);
#pragma unroll
        for (int ks = 0; ks < 8; ++ks)
#pragma unroll
            for (int nt = 0; nt < 2; ++nt) acc[nt] = MFMA16(bfr[ks][nt], afr[ks], acc[nt]);
        if (MODE == 0 && kc >= 1) {
#pragma unroll
            for (int nt = 0; nt < 2; ++nt) { f32x4 r;
                const unsigned num = kc == 1 ? gpl[0][nt] : (kc == 2 ? gpl[1][nt] : (kc == 3 ? gpl[2][nt] : gpl[3][nt])), den = kc == 1 ? gpl[1][nt] : (kc == 2 ? gpl[2][nt] : gpl[3][nt]);
                if (kc < 4) {
#pragma unroll
                    for (int e = 0; e < 4; ++e) r[e] = (float)((num >> (8 * e)) & 0xffu) * __builtin_amdgcn_rcpf((float)((den >> (8 * e)) & 0xffu)); }
                else {
#pragma unroll
                    for (int e = 0; e < 4; ++e) r[e] = (float)((num >> (8 * e)) & 0xffu) * (1.f / 256.f); }
                acc[nt] = acc[nt] * r; } }
        cur ^= 1;
    }
    const size_t row = (size_t)(row0 + m0 + c);
    if (MODE == 2) { const float sc = (col0 >= C_RK && col0 < C_RV) ? 0.125f : 1.f; bf16_t* oq = (bf16_t*)(p.ws + WS_PXA) + row * PXW + col0 + n0 + 4 * g4;
#pragma unroll
        for (int nt = 0; nt < 2; ++nt) { u32x2 w; w.x = pk2(acc[nt][0] * sc, acc[nt][1] * sc); w.y = pk2(acc[nt][2] * sc, acc[nt][3] * sc); *(u32x2*)(oq + nt * 16) = w; }
        return; }
    bf16_t* op = outbase + row * D + col0 + n0 + 4 * g4;
    float ss = 0.f;
#pragma unroll
    for (int nt = 0; nt < 2; ++nt) { u32x2 w; w.x = pk2(acc[nt][0], acc[nt][1]); w.y = pk2(acc[nt][2], acc[nt][3]); st_wt8(op + nt * 16, w);
        ss += (acc[nt][0] * acc[nt][0] + acc[nt][1] * acc[nt][1]) + (acc[nt][2] * acc[nt][2] + acc[nt][3] * acc[nt][3]); }
    if (MODE == 1) { ss += __shfl_xor(ss, 16); ss += __shfl_xor(ss, 32);
        if (g4 == 0) st_wt4((float*)(p.ws + WS_SSP2) + row * 32 + (col0 >> 6) * 2 + (n0 >> 5), ss); }
}

__device__ __forceinline__ int q_take(const F& f, unsigned* ctr) {
    f.qpar ^= 4u;
    unsigned tk = 0u;
    if (f.tid == 0) tk = __hip_atomic_fetch_add(ctr, 1u, __ATOMIC_RELAXED, __HIP_MEMORY_SCOPE_AGENT);
    asm volatile("s_waitcnt vmcnt(0)" ::: "memory");
    if (f.tid == 0) *(volatile LAS unsigned*)(f.lds + LDS_Q + f.qpar) = tk;
    __syncthreads();
    if (f.pend) { if (f.tid == 0) __hip_atomic_fetch_add(f.pend, f.pendn, __ATOMIC_RELAXED, __HIP_MEMORY_SCOPE_AGENT); f.pend = nullptr; }
    return (int)*(volatile LAS unsigned*)(f.lds + LDS_Q + f.qpar);
}
__device__ __forceinline__ void ph_mix(const P& p, const F& f0, int l_, int rep) {
    F f = f0;
    const bool upd = l_ < DEPTH - 1;
    unsigned* ctr = (unsigned*)(p.ws + WS_CTL) + CW_Q + (l_ * 2 + 0) * 64 + rep * 32;
    __syncthreads(); fft_trig(f);
    for (int ci = f.wave; ci < 51; ci += NWAVES) { const bool fa1 = ci < 34; const int k = fa1 ? ci : ci - 34;
        __builtin_amdgcn_global_load_lds((const unsigned*)(p.ws + (fa1 ? WS_FA1 : WS_FA2) + k * 1024 + f.lane * 16), (LAS unsigned*)(f.lds + (fa1 ? LDS_FA : LDS_FA2) + k * 1024), 16, 0, 0); }
    const int nq = (upd ? 256 + 16 + 272 + 256 + 64 + 272 + 64 : 256 + 272 + 256 + 272 + 64) + 256 + 544;
    for (int t = q_take(f, ctr); t < nq; t = q_take(f, ctr)) {
        asm volatile("" : "+v"(f.tid)); f.lane = f.tid & 63;
        int l = l_; asm volatile("" : "+s"(l));
        int r = t;
#define DUP(T, ...) do { if (REP_SUB == (T)) { f.dup = 1; __VA_ARGS__; __syncthreads(); f.dup = 0; } __VA_ARGS__; } while (0)
        if (r < 768) { const int q = (int)((unsigned)r / 3u), m = r - 3 * q;
            if (m == 1) { DUP(3, conv_unit(p, f, l, q)); continue; }
            if (m == 2) { DUP(1, ret1_unit(p, f, l, q)); continue; }
            r = q; }
        else { r -= 768; if (r < 16) { DUP(3, conv_unit(p, f, l, 256 + r)); continue; } r -= 16; if (r < 16) { DUP(1, ret1_unit(p, f, l, 256 + r)); continue; } r -= 16; r += 256; }
        if (r < 256) { DUP(0, attn_unit(p, f, l, false, r >> 6, (r >> 5) & 1, r & 31)); continue; } r -= 256;
        if (l < DEPTH - 1) { if (r < 16) { attn_unit(p, f, l, true, r >> 2, (r >> 1) & 1, r & 1); continue; } r -= 16; }
        if (r < 256) { DUP(2, fft1_unit(p, f, l, r)); continue; } r -= 256;
        if (l < DEPTH - 1) { if (r < 64) { fctx_unit(p, f, r); continue; } r -= 64; }
        if (r < 64) { DUP(4, scan_unit(p, f, l, r)); continue; } r -= 64;
        if (r < 256) { DUP(5, fft2_unit(p, f, l, r)); continue; } r -= 256;
        if (upd || (r % 34) >= 2) DUP(6, ret2_unit(p, f, l, r));
#undef DUP
    }
}

#define KAS __attribute__((address_space(4)))
__device__ __forceinline__ P load_args() {
    const char KAS* k = (const char KAS*)__builtin_amdgcn_kernarg_segment_ptr(); asm volatile("" : "+s"(k));
    P q;
#define LDF(field) q.field = *(const decltype(P::field) KAS*)(k + __builtin_offsetof(P, field))
    LDF(x); LDF(c); LDF(ctx); LDF(cctx); LDF(w_ada); LDF(b_ada); LDF(norm_pre); LDF(norm_post); LDF(w_in); LDF(sink); LDF(conv_w); LDF(conv_b); LDF(ret_decay);
    q.w_o[0] = *(const float* const KAS*)(k + __builtin_offsetof(P, w_o)); q.w_o[1] = *(const float* const KAS*)(k + __builtin_offsetof(P, w_o) + 8); q.w_o[2] = *(const float* const KAS*)(k + __builtin_offsetof(P, w_o) + 16); q.w_o[3] = *(const float* const KAS*)(k + __builtin_offsetof(P, w_o) + 24);
    LDF(w_out); LDF(out); LDF(ws); q.ph_lo = 0; q.ph_hi = 0; q.coop = 0; q.pad = 0;
#undef LDF
    return q;
}

__global__ void __launch_bounds__(NTHR) mega(P pk) {
    extern __shared__ __attribute__((aligned(16))) unsigned char lds_raw[];
#define MKF F f; f.lds = (LAS unsigned char*)lds_raw; { int t_ = threadIdx.x; asm volatile("" : "+v"(t_)); f.tid = t_; } f.lane = f.tid & 63; f.wave = __builtin_amdgcn_readfirstlane(f.tid >> 6); \
    f.bid = blockIdx.x; f.nb = gridDim.x; f.gw = f.bid * NWAVES + f.wave; f.ngw = f.nb * NWAVES; f.dup = 0; f.pend = nullptr; f.pendn = 1u; f.qpar = 0u;
    volatile LAS unsigned* bst = (volatile LAS unsigned*)((LAS unsigned char*)lds_raw + LDS_BYTES - 16);
    if (threadIdx.x < 4) bst[threadIdx.x] = 0u;
    __syncthreads();
    XcdBarrier bar = xcd_barrier_post((unsigned*)(pk.ws + WS_CTL), bst);
    const int ph_lo_ = pk.ph_lo, ph_hi_ = pk.ph_hi, coop_ = pk.coop;
    int ph = 0;
#define PHASE(T, ...) do { if (ph >= ph_lo_ && ph < ph_hi_) { { const int rep_ = 0; (void)rep_; const P p = load_args(); MKF; __VA_ARGS__; } if (REP_PHASE == (T)) { const int rep_ = 1; (void)rep_; const P p = load_args(); MKF; __VA_ARGS__; } if (coop_ && ph + 1 < ph_hi_) { if (coop_ == 2) cg::this_grid().sync(); else xcd_barrier(bar); if (REP_SYNC) { xcd_barrier(bar); xcd_barrier(bar); } } } ++ph; } while (0)
#define PHASE_NB(T, ...) do { if (ph >= ph_lo_ && ph < ph_hi_) { { const int rep_ = 0; (void)rep_; const P p = load_args(); MKF; __VA_ARGS__; } __syncthreads(); } ++ph; } while (0)
#define SUB(T, ...) do { __VA_ARGS__; if (REP_SUB == (T)) { __VA_ARGS__; } } while (0)
    PHASE(0, ph_mod(p, f));
    PHASE(1, ph_prologue(p, f));
    for (int l = 0; l < DEPTH; ++l) {
        PHASE(2, { pg8::Gemm g{hxbuf(p.ws, l), (const bf16_t*)(p.ws + WS_WIN + l * WIN_L), D};
                EpiIn E{(bf16_t*)(p.ws + WS_PXA), (bf16_t*)(p.ws + WS_GATES), (const float*)(p.ws + WS_ROPE), (const float*)(p.ws + WS_ROPE) + 1024, (PROBE_NOST && rep_ == 1) ? 1 : 0};
                unsigned* hgate = l > 0 ? (unsigned*)(p.ws + WS_CTL) + CW_HP + l * 80 * 16 : nullptr;
                if (l < DEPTH - 1) { pg8::OrderFull<68, 32> S_; S_.so.init(f.nb, f.bid); S_.nt = 16; S_.gate = hgate; pg8::gemm_phase<EpiIn, pg8::OrderFull<68, 32>, true, true>(f.lds, g, S_, E);
                    const int nbusy = 68 * 32 - 8 * (int)f.nb;
                    if ((int)f.bid >= nbusy && nbusy >= 0) {
                        __syncthreads();
                        conv_stream(p, l + 1, NC_FF + ((int)f.bid - nbusy) * NWAVES + f.wave, ((int)f.nb - nbusy) * NWAVES, N_CONV_ITEMS, (LAS float*)(f.lds + f.wave * 8448), f.lane);
                        __syncthreads(); } }
                else {
                    pg8::OrderFull<64, 32> S_; S_.so.init(f.nb, f.bid); S_.nt = 16; S_.gate = hgate; pg8::gemm_phase<EpiIn, pg8::OrderFull<64, 32>, true, true>(f.lds, g, S_, E);
                    for (int u = f.bid; u < 192; u += f.nb) { const int ctile = u % 12, rt = u / 12, col0 = (ctile < 4 ? 512 : 2560 - 256) + ctile * 64;
                        unit_poll(f, hgate + (64 + (rt >> 2)) * 16, 256u); gemm64_unit<2>(p, f, g.A, g.Bt, D, D, LATROWS + rt * 64, col0); } } });
        PHASE(3, ph_mix(p, f, l, rep_));
        PHASE_NB(5, { pg8::Gemm g{(const bf16_t*)(p.ws + WS_Y), (const bf16_t*)(p.ws + WS_WO + l * WO_L), YW}; pg8::OrderBranch<64, 4> S_; S_.so.init(f.nb, f.bid); S_.pub = (unsigned*)(p.ws + WS_CTL) + CW_TP + l * 64 * 16;
                EpiWo E{(const unsigned char*)(p.ws + WS_GATES), hxbuf(p.ws, l)};
                pg8::gemm_phase<EpiWo, pg8::OrderBranch<64, 4>, true, true>(f.lds, g, S_, E);
                if (l < DEPTH - 1) for (int u = f.bid; u < 256; u += f.nb) { gemm64_unit<0>(p, f, g.A, g.Bt, YW, YW, LATROWS + (u >> 4) * 64, (u & 15) * 64, hxbuf(p.ws, l)); unit_publish(f, (unsigned*)(p.ws + WS_CTL) + CW_TC + (l * 16 + (u >> 4)) * 16); } });
        PHASE_NB(6, { pg8::Gemm g{hxbuf(p.ws, l), (const bf16_t*)(p.ws + WS_WOUT + l * WOUT_L), D}; pg8::OrderFull<64, 4> S_; S_.so.init(f.nb, f.bid); S_.nt = 16; S_.gate = (unsigned*)(p.ws + WS_CTL) + CW_TP + l * 64 * 16;
                if (l == 0) { EpiOutFused<0> E{p.x, p.out, p.ws, p.norm_post, p.norm_pre, l}; pg8::gemm_phase<EpiOutFused<0>, pg8::OrderFull<64, 4>, false, true>(f.lds, g, S_, E); }
                else if (l == DEPTH - 1) { EpiOutFused<2> E{p.x, p.out, p.ws, p.norm_post, p.norm_pre, l}; pg8::gemm_phase<EpiOutFused<2>, pg8::OrderFull<64, 4>, false, true>(f.lds, g, S_, E); }
                else { EpiOutFused<1> E{p.x, p.out, p.ws, p.norm_post, p.norm_pre, l}; pg8::gemm_phase<EpiOutFused<1>, pg8::OrderFull<64, 4>, false, true>(f.lds, g, S_, E); }
                if (l < DEPTH - 1) {
                    const int cskew = (l + 1 < DEPTH - 1 && f.nb == 256) ? 128 : 0, cu0 = cskew ? (int)f.bid - cskew : (int)f.bid, cus = cskew ? 128 : (int)f.nb;
                    if (cu0 >= 0) for (int u = cu0; u < 256; u += cus) { unit_poll(f, (unsigned*)(p.ws + WS_CTL) + CW_TC + (l * 16 + (u >> 4)) * 16, 16u);
                        gemm64_unit<1>(p, f, g.A, g.Bt, D, D, LATROWS + (u >> 4) * 64, (u & 15) * 64, (bf16_t*)(p.ws + WS_OUTC) - (size_t)LATROWS * D); unit_publish(f, (unsigned*)(p.ws + WS_CTL) + CW_CP + (l * 16 + (u >> 4)) * 16); }
                    if (cu0 >= 0) for (int q = cu0; q < 128; q += cus) { unit_poll(f, (unsigned*)(p.ws + WS_CTL) + CW_CP + (l * 16 + (q >> 3)) * 16, 16u);
                        post_row(p, f, l, LATROWS + q * 8 + f.wave); } } });
    }
#undef PHASE
#undef PHASE_NB
#undef SUB
}
constexpr int N_PHASES = 2 + 4 * DEPTH;

extern "C" void kernel_launch(void* const* d_in, const int* in_sizes, int n_in, void* d_out, int out_size, void* d_ws, size_t ws_size, hipStream_t stream) {
    static int grid = 0;
    if (grid == 0) {
        if (ws_size < WS_END) { fprintf(stderr, "kernel_launch: workspace too small: %zu < %zu\n", ws_size, (size_t)WS_END); grid = -1; return; }
        int dev = 0, cus = 0;
        hipGetDevice(&dev); hipDeviceGetAttribute(&cus, hipDeviceAttributeMultiprocessorCount, dev);
        hipFuncSetAttribute((const void*)mega, hipFuncAttributeMaxDynamicSharedMemorySize, LDS_BYTES);
        int per_cu = 0; hipOccupancyMaxActiveBlocksPerMultiprocessor(&per_cu, (const void*)mega, NTHR, LDS_BYTES);
        if (per_cu < 1) { fprintf(stderr, "kernel_launch: occupancy query says %d blocks/CU\n", per_cu); }
        (void)hipGetLastError();
        grid = cus;
    }
    if (grid < 0) return;
    hipMemsetAsync((char*)d_ws + WS_CTL, 0, CTL_BYTES, stream);
    P p{};
    p.x = (const float*)d_in[0]; p.c = (const float*)d_in[1]; p.ctx = (const float*)d_in[2]; p.cctx = (const float*)d_in[3]; p.w_ada = (const float*)d_in[4]; p.b_ada = (const float*)d_in[5];
    p.norm_pre = (const float*)d_in[6]; p.norm_post = (const float*)d_in[7]; p.w_in = (const float*)d_in[8]; p.sink = (const float*)d_in[9]; p.conv_w = (const float*)d_in[10]; p.conv_b = (const float*)d_in[11];
    p.ret_decay = (const float*)d_in[12]; p.w_o[0] = (const float*)d_in[13]; p.w_o[1] = (const float*)d_in[14]; p.w_o[2] = (const float*)d_in[15]; p.w_o[3] = (const float*)d_in[16]; p.w_out = (const float*)d_in[17];
    p.out = (float*)d_out; p.ws = (unsigned char*)d_ws;
#if MK_COOP
    p.ph_lo = 0; p.ph_hi = N_PHASES; p.coop = 1;
    void* args[] = {&p};
    hipError_t e = hipLaunchCooperativeKernel((const void*)mega, dim3(grid), dim3(NTHR), args, LDS_BYTES, stream);
    if (e != hipSuccess) fprintf(stderr, "cooperative launch failed: %s\n", hipGetErrorString(e));
#else
    for (int ph = 0; ph < N_PHASES; ++ph) { p.ph_lo = ph; p.ph_hi = ph + 1; p.coop = 0; hipLaunchKernelGGL(mega, dim3(grid), dim3(NTHR), LDS_BYTES, stream, p); }
#endif
}
```
